# Optimizing an MI355X kernel written in HIP

```python
import jax, jax.numpy as jnp
from jax import lax
import numpy as np

D_MODEL = 2048
BATCH = 16
SEQ = 2048
DEPTH = 1

CHUNK = 64
MIX_WIDTH = D_MODEL
POOL_WIDTH = MIX_WIDTH // 2
POOL_WINDOWS = (2, 4, 8, 16)
POOL_GROUP = POOL_WIDTH // len(POOL_WINDOWS)
HGRN_WIDTH = MIX_WIDTH - POOL_WIDTH
HGRN_HEAD_DIM = 128
HGRN_HEADS = HGRN_WIDTH // HGRN_HEAD_DIM
IN_WIDTH = POOL_WIDTH + 4 * HGRN_WIDTH
D_FF = 4 * D_MODEL
EPS = 1e-6

kernel_name = "hybrid_pool_hgrn2_sandwich_block"


def rmsnorm(x, w):
    xf = x.astype(jnp.float32)
    r = xf * lax.rsqrt(jnp.mean(xf * xf, axis=-1, keepdims=True) + EPS)
    return (r * w.astype(jnp.float32)).astype(x.dtype)


def pool_mixer(u, pool_w, pool_b, pool_scale):
    B, S, _ = u.shape
    uf = u.astype(jnp.float32)
    c = jnp.cumsum(uf, axis=1)
    pos = jnp.arange(S)
    outs = []
    for j, w in enumerate(POOL_WINDOWS):
        sl = slice(j * POOL_GROUP, (j + 1) * POOL_GROUP)
        cj = c[..., sl]
        shifted = jnp.pad(cj, ((0, 0), (w, 0), (0, 0)))[:, :S]
        cnt = jnp.minimum(pos + 1, w).astype(jnp.float32)[None, :, None]
        dj = ((cj - shifted) / cnt - uf[..., sl]).astype(u.dtype)
        outs.append(dj @ pool_w[j] + pool_b[j])
    return jnp.concatenate(outs, axis=-1) * pool_scale


def hgrn2_chunk_scan(q, k, v, logf):
    B, S, H, Dk = q.shape
    Dv = v.shape[-1]
    N = S // CHUNK

    def to_chunks(a):
        return a.reshape(B, N, CHUNK, H, a.shape[-1]).transpose(1, 0, 3, 2, 4)

    causal = jnp.tril(jnp.ones((CHUNK, CHUNK), dtype=bool))[None, None, :, :, None]

    def step(state, inp):
        q_c, k_c, v_c, g_c = inp
        b = jnp.cumsum(g_c, axis=2)
        o_inter = jnp.einsum('bhtd,bhde->bhte', q_c * jnp.exp(b), state)
        diff = b[:, :, :, None, :] - b[:, :, None, :, :]
        decay = jnp.exp(jnp.where(causal, diff, -jnp.inf))
        scores = jnp.einsum('bhtd,bhsd,bhtsd->bhts', q_c, k_c, decay)
        o_intra = jnp.einsum('bhts,bhse->bhte', scores, v_c)
        b_last = b[:, :, -1:, :]
        new_state = jnp.exp(b_last[:, :, 0, :])[..., None] * state + jnp.einsum(
            'bhsd,bhse->bhde', k_c * jnp.exp(b_last - b), v_c)
        return new_state, o_inter + o_intra

    init = jnp.zeros((B, H, Dk, Dv), jnp.float32)
    _, o = lax.scan(step, init, (to_chunks(q), to_chunks(k), to_chunks(v), to_chunks(logf)))
    return o.transpose(1, 0, 3, 2, 4).reshape(B, S, H, Dv)


def hgrn2_mixer(q, f_pre, i, g, lb, norm_w):
    B, S, _ = q.shape
    shp = (B, S, HGRN_HEADS, HGRN_HEAD_DIM)
    qf = q.astype(jnp.float32).reshape(shp)
    vf = i.astype(jnp.float32).reshape(shp)
    sig = jax.nn.sigmoid(f_pre.astype(jnp.float32)).reshape(shp)
    lbh = lb.reshape(HGRN_HEADS, HGRN_HEAD_DIM)
    f = lbh + (1.0 - lbh) * sig
    k = (1.0 - lbh) * (1.0 - sig)
    o = hgrn2_chunk_scan(qf, k, vf, jnp.log(f))
    o = o * jax.nn.sigmoid(g.astype(jnp.float32)).reshape(shp)
    o = o * lax.rsqrt(jnp.mean(o * o, axis=-1, keepdims=True) + EPS)
    o = o * norm_w.astype(jnp.float32).reshape(HGRN_HEADS, HGRN_HEAD_DIM)
    return o.reshape(B, S, HGRN_WIDTH).astype(q.dtype)


def setup_inputs(seed: int = 0) -> dict:
    key = jax.random.key(seed)
    ks = jax.random.split(key, 16)
    f32 = jnp.float32
    nrm = lambda k, s, sc: jax.random.normal(k, s, f32) * sc
    gain = lambda k, s: 1.0 + 0.05 * jax.random.normal(k, s, f32)
    return {
        "x": jax.random.normal(ks[0], (BATCH, SEQ, D_MODEL), f32),
        "w_in": nrm(ks[1], (DEPTH, D_MODEL, IN_WIDTH), D_MODEL ** -0.5),
        "pool_w": nrm(ks[2], (DEPTH, len(POOL_WINDOWS), POOL_GROUP, POOL_GROUP), POOL_GROUP ** -0.5),
        "pool_b": nrm(ks[3], (DEPTH, len(POOL_WINDOWS), POOL_GROUP), 0.02),
        "pool_scale": gain(ks[4], (DEPTH, POOL_WIDTH)),
        "lb_logits": nrm(ks[5], (DEPTH + 1, HGRN_WIDTH), 0.5),
        "hgrn_norm_w": gain(ks[6], (DEPTH, HGRN_WIDTH)),
        "w_out": nrm(ks[7], (DEPTH, MIX_WIDTH, D_MODEL), MIX_WIDTH ** -0.5),
        "norm_mix_pre": gain(ks[8], (DEPTH, D_MODEL)),
        "norm_mix_post": gain(ks[9], (DEPTH, D_MODEL)),
        "norm_mlp_pre": gain(ks[10], (DEPTH, D_MODEL)),
        "norm_mlp_post": gain(ks[11], (DEPTH, D_MODEL)),
        "w_mlp_in": nrm(ks[12], (DEPTH, D_MODEL, D_FF), D_MODEL ** -0.5),
        "w_mlp_out": nrm(ks[13], (DEPTH, D_FF, D_MODEL), D_FF ** -0.5),
    }


def reference(x, w_in, pool_w, pool_b, pool_scale, lb_logits, hgrn_norm_w, w_out,
              norm_mix_pre, norm_mix_post, norm_mlp_pre, norm_mlp_post,
              w_mlp_in, w_mlp_out):
    lb_all = jnp.cumsum(jax.nn.softmax(lb_logits.astype(jnp.float32), axis=0), axis=0)
    P, H4 = POOL_WIDTH, HGRN_WIDTH
    for l in range(DEPTH):
        h = rmsnorm(x, norm_mix_pre[l])
        proj = h @ w_in[l]
        u_pool = proj[..., :P]
        q = proj[..., P:P + H4]
        f_pre = proj[..., P + H4:P + 2 * H4]
        i = proj[..., P + 2 * H4:P + 3 * H4]
        g = proj[..., P + 3 * H4:P + 4 * H4]
        y_pool = pool_mixer(u_pool, pool_w[l], pool_b[l], pool_scale[l])
        y_hgrn = hgrn2_mixer(q, f_pre, i, g, lb_all[l], hgrn_norm_w[l])
        mix = jnp.concatenate([y_pool, y_hgrn], axis=-1) @ w_out[l]
        x = x + rmsnorm(mix, norm_mix_post[l])
        h = rmsnorm(x, norm_mlp_pre[l])
        ff = jnp.square(jax.nn.relu(h @ w_mlp_in[l])) @ w_mlp_out[l]
        x = x + rmsnorm(ff, norm_mlp_post[l])
    return x
```

```cpp
#include <hip/hip_runtime.h>
#include <hip/hip_cooperative_groups.h>
#include <cstdio>
#include <cstdint>
namespace cg = cooperative_groups;

#define LAS __attribute__((address_space(3)))
typedef unsigned short bf16_t;
typedef short bf16x8 __attribute__((ext_vector_type(8)));
typedef float f32x4 __attribute__((ext_vector_type(4)));
typedef float f32x2 __attribute__((ext_vector_type(2)));
typedef unsigned u32x4 __attribute__((ext_vector_type(4)));
typedef unsigned u32x2 __attribute__((ext_vector_type(2)));

constexpr int NB = 16, SEQ = 2048, DM = 2048, M = NB * SEQ;
constexpr int PW = 1024, HW = 1024, INW = PW + 4 * HW, FFW = 4 * DM, NHEAD = 8, HD = 128, CHUNK = 64, NCHUNK = SEQ / CHUNK;
constexpr float EPS = 1e-6f;
constexpr int NTHREADS = 512, NWAVES = 8;
constexpr int LDS_BYTES = 138 * 1024;
constexpr int XCH_OFF = 131072 + 512;

constexpr size_t MiB = 1u << 20;
constexpr size_t WS_WIN = 2 * MiB, WS_WOUT = 22 * MiB, WS_W1 = 30 * MiB, WS_W2 = 62 * MiB, WS_WPOOL = 94 * MiB;
constexpr size_t WS_SS1 = 96 * MiB, WS_SS2 = 100 * MiB;
constexpr size_t WS_BAR = 65536;
constexpr size_t WS_Y = 744 * MiB;
constexpr size_t WS_RINV = 95 * MiB + 512 * 1024;
constexpr size_t WS_R2 = 95 * MiB;
constexpr size_t WS_HN = 104 * MiB;
constexpr size_t WS_MIX = 232 * MiB;
constexpr size_t WS_D = 360 * MiB;
constexpr size_t WS_PROJ = 424 * MiB;
constexpr size_t WS_FFH = 424 * MiB;
constexpr size_t WS_END = 936 * MiB;

typedef __bf16 bf16x2_t __attribute__((ext_vector_type(2)));
__device__ __forceinline__ unsigned cvt_pk_bf16(float lo, float hi) { f32x2 v = {lo, hi}; bf16x2_t b = __builtin_convertvector(v, bf16x2_t); return __builtin_bit_cast(unsigned, b); }
__device__ __forceinline__ float bf_lo(unsigned u) { return __builtin_bit_cast(float, u << 16); }
__device__ __forceinline__ float bf_hi(unsigned u) { return __builtin_bit_cast(float, u & 0xffff0000u); }
__device__ __forceinline__ float wave_sum(float v) {
#pragma unroll
    for (int o = 1; o < 64; o <<= 1) v += __shfl_xor(v, o);
    return v;
}
__device__ __forceinline__ float sigmoidf_(float x) { return __builtin_amdgcn_rcpf(1.0f + __expf(-x)); }
#define LDS_WAIT() asm volatile("s_waitcnt lgkmcnt(0)" ::: "memory")
__device__ __forceinline__ int opaque_tid() { int t = threadIdx.x; asm volatile("" : "+v"(t)); return t; }

namespace pg8 {
constexpr int BM = 256, BK = 64, HALF = 128, HTB = HALF * BK * 2, STAGE_BYTES = 8 * HTB, NXCD = 8, WGM = 8;
__host__ __device__ __forceinline__ int lds_byte(int r, int c) { const int st = (r >> 4) * 2 + (c >> 5), rr = r & 15, cc = c & 31, ob = rr * 64 + cc * 2; return st * 1024 + (ob ^ (((ob >> 9) & 1) << 5)); }
__host__ __device__ __forceinline__ void stage_rc(int b, int& R, int& C) { const int st = b / 1024, sb = b % 1024, swz = sb ^ (((sb >> 9) & 1) << 5); R = (st >> 1) * 16 + swz / 64; C = (st & 1) * 32 + (swz % 64) / 2; }
__host__ __device__ __forceinline__ int perm32(int rho) { const int n = rho >> 4, i = rho & 15; return 8 * (i >> 2) + 4 * n + (i & 3); }

struct Unit { int pm, pn; };
struct Gemm { const bf16_t* A; const bf16_t* Bt; int lda, ldb, K, a_pn_bytes; };

struct StaticOrder {
    int nM, nN, nwg, G, c;
    __device__ void init(int M_, int N_, int G_, int c_) { nM = M_ / BM; nN = N_ / BM; nwg = nM * nN; G = G_; c = c_; }
    __device__ bool next(int i, Unit& u) const {
        const long L = (long)i * G + c; if (L >= nwg) return false;
        int wgid = (int)L; { const int q = nwg / NXCD, r = nwg % NXCD, xcd = wgid % NXCD, off = wgid / NXCD; wgid = (xcd < r ? xcd * (q + 1) : r * (q + 1) + (xcd - r) * q) + off; }
        const int nig = WGM * nN, gid = wgid / nig, fm = gid * WGM, gsz = (nM - fm) < WGM ? (nM - fm) : WGM;
        u.pm = fm + ((wgid % nig) % gsz); u.pn = (wgid % nig) / gsz; return true;
    }
};

struct PanelOrder {
    int pb, NP, nM;
    __device__ bool next(int i, Unit& u) const { const int pm = pb + (i >> 2) * NP; if (pm >= nM) return false; u.pm = pm; u.pn = i & 3; return true; }
};

template <int MODE> struct Epi {
    static constexpr bool FUSED = false;
    bf16_t* O; int ldc; const float* bias; const float* scale; float* ss;
    __device__ __forceinline__ void operator()(const f32x4 (&acc)[2][2][4][2], const Unit& u, int wr, int wc, int fr, int fq) const {
        const int row0 = u.pm * BM + wr * 64 + fr; const int col0 = u.pn * BM + wc * 32 + 8 * fq;
        if (MODE == 4) {
            const int kind = u.pn >> 2;
#pragma unroll
            for (int bj = 0; bj < 2; ++bj) {
                float om[8];
                if (kind == 2) {
                    const int hc = col0 + bj * HALF - (PW + HW);
#pragma unroll
                    for (int e = 0; e < 8; ++e) om[e] = __builtin_amdgcn_rcpf(1.0f + __expf(bias[hc + e] - bias[HW + hc + e]));
                }
#pragma unroll
                for (int ai = 0; ai < 2; ++ai)
#pragma unroll
                    for (int m = 0; m < 4; ++m) {
                        const int row = row0 + ai * HALF + m * 16;
                        f32x4 v0 = acc[ai][bj][m][0], v1 = acc[ai][bj][m][1];
                        if (kind == 2) {
#pragma unroll
                            for (int e = 0; e < 4; ++e) { v0[e] = om[e] * __builtin_amdgcn_rcpf(1.0f + __expf(v0[e])); v1[e] = om[4 + e] * __builtin_amdgcn_rcpf(1.0f + __expf(v1[e])); }
                        } else if (kind == 4) {
#pragma unroll
                            for (int e = 0; e < 4; ++e) { v0[e] = __builtin_amdgcn_rcpf(1.0f + __expf(-v0[e])); v1[e] = __builtin_amdgcn_rcpf(1.0f + __expf(-v1[e])); }
                        }
                        u32x4 w; w.x = cvt_pk_bf16(v0[0], v0[1]); w.y = cvt_pk_bf16(v0[2], v0[3]); w.z = cvt_pk_bf16(v1[0], v1[1]); w.w = cvt_pk_bf16(v1[2], v1[3]);
                        *(u32x4*)(O + (size_t)row * ldc + col0 + bj * HALF) = w;
                    }
            }
            return;
        }
        if (MODE == 2) {
#pragma unroll
            for (int bj = 0; bj < 2; ++bj) {
                const f32x4 b0 = *(const f32x4*)(bias + col0 + bj * HALF) * *(const f32x4*)(scale + col0 + bj * HALF);
                const f32x4 b1 = *(const f32x4*)(bias + col0 + bj * HALF + 4) * *(const f32x4*)(scale + col0 + bj * HALF + 4);
#pragma unroll
                for (int ai = 0; ai < 2; ++ai)
#pragma unroll
                    for (int m = 0; m < 4; ++m) {
                        const int row = row0 + ai * HALF + m * 16;
                        const f32x4 v0 = acc[ai][bj][m][0] + b0, v1 = acc[ai][bj][m][1] + b1;
                        u32x4 w; w.x = cvt_pk_bf16(v0[0], v0[1]); w.y = cvt_pk_bf16(v0[2], v0[3]); w.z = cvt_pk_bf16(v1[0], v1[1]); w.w = cvt_pk_bf16(v1[2], v1[3]);
                        *(u32x4*)(O + (size_t)row * ldc + col0 + bj * HALF) = w;
                    }
            }
            return;
        }
#pragma unroll
        for (int ai = 0; ai < 2; ++ai)
#pragma unroll
            for (int m = 0; m < 4; ++m) {
                const int row = row0 + ai * HALF + m * 16;
                bf16_t* rowp = O + (size_t)row * ldc + col0; float s = 0.f;
                const float rsc = (MODE == 1) ? scale[row] : 1.0f;
#pragma unroll
                for (int bj = 0; bj < 2; ++bj) {
                    f32x4 v0 = acc[ai][bj][m][0], v1 = acc[ai][bj][m][1];
                    if (MODE == 1) {
#pragma unroll
                        for (int e = 0; e < 4; ++e) { float a = fmaxf(v0[e] * rsc, 0.f), b = fmaxf(v1[e] * rsc, 0.f); v0[e] = a * a; v1[e] = b * b; }
                    }
                    if (MODE == 3) { s += (v0[0] * v0[0] + v0[1] * v0[1]) + (v0[2] * v0[2] + v0[3] * v0[3]) + (v1[0] * v1[0] + v1[1] * v1[1]) + (v1[2] * v1[2] + v1[3] * v1[3]); }
                    u32x4 w; w.x = cvt_pk_bf16(v0[0], v0[1]); w.y = cvt_pk_bf16(v0[2], v0[3]); w.z = cvt_pk_bf16(v1[0], v1[1]); w.w = cvt_pk_bf16(v1[2], v1[3]);
                    *(u32x4*)(rowp + bj * HALF) = w;
                }
                if (MODE == 3) { s += __shfl_xor(s, 16); s += __shfl_xor(s, 32); if (fq == 0) ss[(size_t)row * 32 + u.pn * 4 + wc] = s; }
            }
    }
};

struct FusedOrder {
    int c, G, nM;
    __device__ bool next(int i, Unit& u) const { const int x = c & 7, j = c >> 3, pp = G >> 6; const int pm = (i * 8 + x) * pp + (j >> 3); if ((j >> 3) >= pp || pm >= nM) return false; u.pm = pm; u.pn = j & 7; return true; }
};

__device__ __forceinline__ void xst(unsigned* p, float v) { __hip_atomic_store(p, __builtin_bit_cast(unsigned, v), __ATOMIC_RELAXED, __HIP_MEMORY_SCOPE_AGENT); }
__device__ __forceinline__ float xld(unsigned* p) { return __builtin_bit_cast(float, __hip_atomic_load(p, __ATOMIC_RELAXED, __HIP_MEMORY_SCOPE_AGENT)); }

template <int KIND> struct EpiFused {
    static constexpr bool FUSED = true;
    const float* xres; const bf16_t* x1b_in; bf16_t* x1b_out; float* out; const float* gain;
    unsigned* ssb; unsigned* cnt; unsigned* ssb2; unsigned* cnt2; float* r2; const float* rinv;
    __device__ __forceinline__ void operator()(const f32x4 (&acc)[2][2][4][2], const Unit& u, int wr, int wc, int fr, int fq, LAS unsigned char* xl, int tid) const {
        LAS float* P = (LAS float*)xl; LAS float* R = (LAS float*)(xl + 4096); volatile LAS unsigned* flag = (volatile LAS unsigned*)(xl + 5120); LAS float* RI = (LAS float*)(xl + 5184);
        const int prow = u.pm * BM, col0 = u.pn * BM + wc * 32 + 8 * fq;
        u32x4 pb[(KIND == 6) ? 2 : 1][2][4];
#pragma unroll
        for (int bj = 0; bj < ((KIND == 6) ? 2 : 1); ++bj)
#pragma unroll
            for (int ai = 0; ai < 2; ++ai)
#pragma unroll
                for (int m = 0; m < 4; ++m) { const unsigned off = (unsigned)(prow + ai * HALF + wr * 64 + m * 16 + fr) * (unsigned)DM + (unsigned)(col0 + bj * HALF);
                    pb[bj][ai][m] = *(const u32x4*)(x1b_in + off); }
#pragma unroll
        for (int ai = 0; ai < 2; ++ai)
#pragma unroll
            for (int m = 0; m < 4; ++m) {
                float s = 0.f;
#pragma unroll
                for (int bj = 0; bj < 2; ++bj) { const f32x4 v0 = acc[ai][bj][m][0], v1 = acc[ai][bj][m][1];
                    s += (v0[0] * v0[0] + v0[1] * v0[1]) + (v0[2] * v0[2] + v0[3] * v0[3]) + (v1[0] * v1[0] + v1[1] * v1[1]) + (v1[2] * v1[2] + v1[3] * v1[3]); }
                s += __shfl_xor(s, 16); s += __shfl_xor(s, 32);
                if (fq == 0) P[(ai * HALF + wr * 64 + m * 16 + fr) * 4 + wc] = s;
            }
        asm volatile("s_waitcnt lgkmcnt(0)" ::: "memory"); __builtin_amdgcn_s_barrier(); asm volatile("" ::: "memory");
        if (tid < BM) { const f32x4 q = *(const LAS f32x4*)(P + tid * 4); xst(ssb + (size_t)(prow + tid) * 8 + u.pn, (q.x + q.y) + (q.z + q.w)); }
        asm volatile("s_waitcnt vmcnt(0) lgkmcnt(0)" ::: "memory"); __builtin_amdgcn_s_barrier(); asm volatile("" ::: "memory");
        if (tid == 0) {
            unsigned* cw = cnt + u.pm * 16;
            (void)__hip_atomic_fetch_add(cw, 1u, __ATOMIC_RELAXED, __HIP_MEMORY_SCOPE_AGENT);
            unsigned sp = 0;
            while (__hip_atomic_load(cw, __ATOMIC_RELAXED, __HIP_MEMORY_SCOPE_AGENT) < 8u) { __builtin_amdgcn_s_sleep(1); if (++sp > (1u << 22)) break; }
            __builtin_amdgcn_fence(__ATOMIC_ACQUIRE, "agent");
        }
        asm volatile("s_waitcnt vmcnt(0) lgkmcnt(0)" ::: "memory"); __builtin_amdgcn_s_barrier(); asm volatile("" ::: "memory");
        if (tid < BM) { unsigned* sp8 = ssb + (size_t)(prow + tid) * 8; float s = 0.f;
#pragma unroll
            for (int k = 0; k < 8; ++k) s += xld(sp8 + k);
            R[tid] = rsqrtf(s * (1.0f / DM) + EPS); RI[tid] = (KIND == 5) ? rinv[prow + tid] : 1.0f; }
        asm volatile("s_waitcnt vmcnt(0) lgkmcnt(0)" ::: "memory"); __builtin_amdgcn_s_barrier(); asm volatile("" ::: "memory");
#pragma unroll
        for (int bj = 0; bj < 2; ++bj) {
            const f32x4 g0 = *(const f32x4*)(gain + col0 + bj * HALF), g1 = *(const f32x4*)(gain + col0 + bj * HALF + 4);
            if (KIND == 5 && bj == 1) {
#pragma unroll
                for (int ai = 0; ai < 2; ++ai)
#pragma unroll
                    for (int m = 0; m < 4; ++m) { const unsigned off = (unsigned)(prow + ai * HALF + wr * 64 + m * 16 + fr) * (unsigned)DM + (unsigned)(col0 + HALF);
                        pb[0][ai][m] = *(const u32x4*)(x1b_in + off); }
            }
#pragma unroll
            for (int ai = 0; ai < 2; ++ai) {
                float s2q[4] = {0.f, 0.f, 0.f, 0.f};
#pragma unroll
                for (int m = 0; m < 4; ++m) {
                    const int lrow = ai * HALF + wr * 64 + m * 16 + fr;
                    const unsigned off = (unsigned)(prow + lrow) * (unsigned)DM + (unsigned)(col0 + bj * HALF);
                    const float rr = R[lrow];
                    f32x4 a0, a1;
                    { const u32x4 xb = pb[(KIND == 6) ? bj : 0][ai][m]; a0 = (f32x4){bf_lo(xb.x), bf_hi(xb.x), bf_lo(xb.y), bf_hi(xb.y)}; a1 = (f32x4){bf_lo(xb.z), bf_hi(xb.z), bf_lo(xb.w), bf_hi(xb.w)}; }
                    if (KIND == 5) { const float ri = RI[lrow]; a0 = a0 * ri; a1 = a1 * ri; }
                    const f32x4 v0 = a0 + acc[ai][bj][m][0] * rr * g0, v1 = a1 + acc[ai][bj][m][1] * rr * g1;
                    if (KIND == 5) {
                        u32x4 w; w.x = cvt_pk_bf16(v0[0], v0[1]); w.y = cvt_pk_bf16(v0[2], v0[3]); w.z = cvt_pk_bf16(v1[0], v1[1]); w.w = cvt_pk_bf16(v1[2], v1[3]);
                        *(u32x4*)(x1b_out + off) = w;
                        s2q[m] += (v0[0] * v0[0] + v0[1] * v0[1]) + (v0[2] * v0[2] + v0[3] * v0[3]) + (v1[0] * v1[0] + v1[1] * v1[1]) + (v1[2] * v1[2] + v1[3] * v1[3]);
                    } else { *(f32x4*)(out + off) = v0; *(f32x4*)(out + off + 4) = v1; }
                }
                if (KIND == 5) {
#pragma unroll
                    for (int m = 0; m < 4; ++m) { float t2 = s2q[m]; t2 += __shfl_xor(t2, 16); t2 += __shfl_xor(t2, 32);
                        if (fq == 0) { LAS float* pp = P + (ai * HALF + wr * 64 + m * 16 + fr) * 4 + wc; if (bj == 0) *pp = t2; else *pp += t2; } }
                }
                asm volatile("" ::: "memory");
            }
        }
        if (KIND == 5) {
            asm volatile("s_waitcnt lgkmcnt(0)" ::: "memory"); __builtin_amdgcn_s_barrier(); asm volatile("" ::: "memory");
            if (tid < BM) { const f32x4 q = *(const LAS f32x4*)(P + tid * 4); xst(ssb2 + (size_t)(prow + tid) * 8 + u.pn, (q.x + q.y) + (q.z + q.w)); }
            asm volatile("s_waitcnt vmcnt(0) lgkmcnt(0)" ::: "memory"); __builtin_amdgcn_s_barrier(); asm volatile("" ::: "memory");
            if (tid == 0) flag[0] = __hip_atomic_fetch_add(cnt2 + u.pm * 16, 1u, __ATOMIC_RELAXED, __HIP_MEMORY_SCOPE_AGENT);
            asm volatile("s_waitcnt vmcnt(0) lgkmcnt(0)" ::: "memory"); __builtin_amdgcn_s_barrier(); asm volatile("" ::: "memory");
            if (flag[0] == 7u && tid < BM) { unsigned* sp8 = ssb2 + (size_t)(prow + tid) * 8; float s = 0.f;
#pragma unroll
                for (int k = 0; k < 8; ++k) s += xld(sp8 + k);
                r2[prow + tid] = rsqrtf(s * (1.0f / DM) + EPS); }
            asm volatile("s_waitcnt lgkmcnt(0)" ::: "memory"); __builtin_amdgcn_s_barrier(); asm volatile("" ::: "memory");
        }
    }
};

template <class EpiT, class Sched>
__device__ __forceinline__ void gemm_phase(LAS unsigned char* lds, const Gemm g, const Sched& S, const EpiT& E) {
    int tid_ = threadIdx.x; asm volatile("" : "+v"(tid_));
    const int tid = tid_, wid = __builtin_amdgcn_readfirstlane(tid >> 6), lane = tid & 63, wr = wid >> 2, wc = wid & 3, fr = lane & 15, fq = lane >> 4;
    const int K = g.K, nt = K / BK;
    unsigned voffA[2], voffB[2];
#pragma unroll
    for (int i = 0; i < 2; ++i) { int R, C; stage_rc(tid * 16 + i * 8192, R, C); const int Rb = (R & ~31) + perm32(R & 31);
        voffA[i] = (unsigned)(R * g.lda + C) * 2u; voffB[i] = (unsigned)(Rb * g.ldb + C) * 2u; }
    const size_t kstep = (size_t)(BK * 2);
    const size_t hstepA = (size_t)HALF * g.lda * 2, hstepB = (size_t)HALF * g.ldb * 2;
    const size_t tstepA = 2 * hstepA, tstepB = 2 * hstepB;
    const unsigned ldsw = (unsigned)wid * 1024u;
    const int aoff = lds_byte(wr * 64 + fr, fq * 8), boff = lds_byte(wc * 32 + fr, fq * 8);
#define PG8_SA(b, h) (((b) * 2 + (h)) * HTB)
#define PG8_SB(b, h) ((4 + (b) * 2 + (h)) * HTB)
#define PG8_STAGE(bufoff, gbase, voff) do { _Pragma("unroll") for (int _i = 0; _i < 2; ++_i) \
        __builtin_amdgcn_global_load_lds((const unsigned*)((const char*)(gbase) + (voff)[_i]), (LAS unsigned*)(lds + (bufoff) + ldsw + _i * 8192), 16, 0, 0); } while (0)
#define PG8_LDA(dst, b, h) do { _Pragma("unroll") for (int m = 0; m < 4; ++m) _Pragma("unroll") for (int k = 0; k < 2; ++k) dst[m][k] = *(const LAS bf16x8*)(lds + PG8_SA(b, h) + aoff + m * 2048 + k * 1024); } while (0)
#define PG8_LDB(dst, b, h) do { _Pragma("unroll") for (int n = 0; n < 2; ++n) _Pragma("unroll") for (int k = 0; k < 2; ++k) dst[n][k] = *(const LAS bf16x8*)(lds + PG8_SB(b, h) + boff + n * 2048 + k * 1024); } while (0)
#define PG8_MMA(ai, bj, At, Bt) do { __builtin_amdgcn_s_setprio(1); _Pragma("unroll") for (int m = 0; m < 4; ++m) _Pragma("unroll") for (int n = 0; n < 2; ++n) _Pragma("unroll") for (int k = 0; k < 2; ++k) \
        acc[ai][bj][m][n] = __builtin_amdgcn_mfma_f32_16x16x32_bf16(Bt[n][k], At[m][k], acc[ai][bj][m][n], 0, 0, 0); __builtin_amdgcn_s_setprio(0); } while (0)
#define PG8_WAIT_V(n) asm volatile("s_waitcnt vmcnt(" #n ")" ::: "memory")
#define PG8_WAIT_L(n) asm volatile("s_waitcnt lgkmcnt(" #n ")" ::: "memory")
#define PG8_BAR __builtin_amdgcn_s_barrier()
#define PG8_SCHED __builtin_amdgcn_sched_barrier(0)
    Unit cur, nxt; int ui = 0;
    if (!S.next(0, cur)) return;
    f32x4 acc[2][2][4][2];
#pragma unroll
    for (int a = 0; a < 2; ++a)
#pragma unroll
        for (int b = 0; b < 2; ++b)
#pragma unroll
            for (int m = 0; m < 4; ++m)
#pragma unroll
                for (int n = 0; n < 2; ++n) acc[a][b][m][n] = (f32x4){0.f, 0.f, 0.f, 0.f};
    bf16x8 At[4][2], B0[2][2], B1[2][2];
    const char* cA = (const char*)g.A + (size_t)cur.pm * tstepA + (size_t)cur.pn * g.a_pn_bytes; const char* cB = (const char*)g.Bt + (size_t)cur.pn * tstepB;
    PG8_STAGE(PG8_SB(0, 0), cB, voffB); PG8_STAGE(PG8_SB(0, 1), cB + hstepB, voffB); PG8_STAGE(PG8_SA(0, 0), cA, voffA); PG8_STAGE(PG8_SA(0, 1), cA + hstepA, voffA);
    if (wr == 1) PG8_BAR;
    PG8_WAIT_V(2); PG8_BAR;
    PG8_STAGE(PG8_SB(1, 0), cB + kstep, voffB); PG8_STAGE(PG8_SA(1, 0), cA + kstep, voffA); PG8_STAGE(PG8_SB(1, 1), cB + hstepB + kstep, voffB);
    PG8_WAIT_V(6); PG8_BAR;
    for (;;) {
        const bool has_next = S.next(ui + 1, nxt);
        const char* nA = has_next ? (const char*)g.A + (size_t)nxt.pm * tstepA + (size_t)nxt.pn * g.a_pn_bytes : cA; const char* nB = has_next ? (const char*)g.Bt + (size_t)nxt.pn * tstepB : cB;
#pragma nounroll
        for (int t = 0; t < nt; t += 2) {
            const bool last = (t == nt - 2);
            const char* a1 = cA + (size_t)(t + 1) * kstep;
            const char* a2 = last ? nA : cA + (size_t)(t + 2) * kstep; const char* b2 = last ? nB : cB + (size_t)(t + 2) * kstep;
            const char* a3 = a2 + kstep; const char* b3 = b2 + kstep;
            PG8_LDB(B0, 0, 0); PG8_LDB(B1, 0, 1); PG8_SCHED; PG8_LDA(At, 0, 0); PG8_STAGE(PG8_SA(1, 1), a1 + hstepA, voffA);
            PG8_WAIT_V(8); PG8_WAIT_L(0); PG8_BAR; PG8_MMA(0, 0, At, B0); PG8_MMA(0, 1, At, B1); PG8_BAR; PG8_SCHED;
            PG8_LDA(At, 0, 1); PG8_STAGE(PG8_SB(0, 0), b2, voffB); PG8_STAGE(PG8_SB(0, 1), b2 + hstepB, voffB); PG8_STAGE(PG8_SA(0, 0), a2, voffA);
            PG8_WAIT_V(8); PG8_WAIT_L(0); PG8_BAR; PG8_MMA(1, 0, At, B0); PG8_MMA(1, 1, At, B1); PG8_BAR; PG8_SCHED;
            PG8_LDB(B0, 1, 0); PG8_LDB(B1, 1, 1); PG8_SCHED; PG8_LDA(At, 1, 0); PG8_STAGE(PG8_SA(0, 1), a2 + hstepA, voffA);
            PG8_WAIT_V(8); PG8_WAIT_L(0); PG8_BAR; PG8_MMA(0, 0, At, B0); PG8_MMA(0, 1, At, B1); PG8_BAR; PG8_SCHED;
            PG8_LDA(At, 1, 1); PG8_STAGE(PG8_SB(1, 0), b3, voffB); PG8_STAGE(PG8_SB(1, 1), b3 + hstepB, voffB); PG8_STAGE(PG8_SA(1, 0), a3, voffA);
            PG8_WAIT_V(8); PG8_WAIT_L(0); PG8_BAR; PG8_MMA(1, 0, At, B0); PG8_MMA(1, 1, At, B1); PG8_BAR; PG8_SCHED;
        }
        if (wr == 0) PG8_BAR;
        if constexpr (EpiT::FUSED) E(acc, cur, wr, wc, fr, fq, lds + XCH_OFF, tid); else E(acc, cur, wr, wc, fr, fq);
        if (!has_next) break;
#pragma unroll
        for (int a = 0; a < 2; ++a)
#pragma unroll
            for (int b = 0; b < 2; ++b)
#pragma unroll
                for (int m = 0; m < 4; ++m)
#pragma unroll
                    for (int n = 0; n < 2; ++n) acc[a][b][m][n] = (f32x4){0.f, 0.f, 0.f, 0.f};
        cur = nxt; cA = nA; cB = nB; ++ui;
        if (wr == 1) PG8_BAR;
    }
    PG8_WAIT_V(0);
    PG8_BAR;
#undef PG8_SA
#undef PG8_SB
#undef PG8_STAGE
#undef PG8_LDA
#undef PG8_LDB
#undef PG8_MMA
#undef PG8_WAIT_V
#undef PG8_WAIT_L
#undef PG8_BAR
#undef PG8_SCHED
}
}

__device__ __forceinline__ void p0_transpose_item(const float* W, int K, int N, bf16_t* WT, LAS float* scr, int item, int lane, const float* colscale = nullptr, const float* rowscale = nullptr) {
    const int nblk = N / 32, kb = item / nblk, nb = item % nblk, k0 = 64 * kb, n0 = 32 * nb;
    const int lr = lane >> 3, lc = (lane & 7) * 4;
    f32x4 v[8];
#pragma unroll
    for (int i = 0; i < 8; ++i) v[i] = __builtin_nontemporal_load((const f32x4*)(W + (size_t)(k0 + lr + 8 * i) * N + n0 + lc));
    f32x4 cs = (f32x4){1.f, 1.f, 1.f, 1.f};
    if (colscale) cs = *(const f32x4*)(colscale + n0 + lc);
#pragma unroll
    for (int i = 0; i < 8; ++i) { const int kk = lr + 8 * i; const float rs = rowscale ? rowscale[k0 + kk] : 1.0f; const f32x4 t = v[i] * cs * rs;
        LAS float* d = scr + kk * 33 + lc; d[0] = t.x; d[1] = t.y; d[2] = t.z; d[3] = t.w; }
    LDS_WAIT(); asm volatile("" ::: "memory");
    const int c = lane & 7;
#pragma unroll
    for (int j = 0; j < 4; ++j) { const int n = (lane >> 3) + 8 * j; const LAS float* s = scr + (8 * c) * 33 + n;
        u32x4 o; o.x = cvt_pk_bf16(s[0 * 33], s[1 * 33]); o.y = cvt_pk_bf16(s[2 * 33], s[3 * 33]); o.z = cvt_pk_bf16(s[4 * 33], s[5 * 33]); o.w = cvt_pk_bf16(s[6 * 33], s[7 * 33]);
        *(u32x4*)(WT + (size_t)(n0 + n) * K + k0 + 8 * c) = o; }
    LDS_WAIT(); asm volatile("" ::: "memory");
}

template <int R>
__device__ __forceinline__ void rms_rows_to_bf16(const float* x, float* rinv, bf16_t* o, int m0, int mstride, int lane) {
    f32x4 v[R][8];
#pragma unroll
    for (int r = 0; r < R; ++r) { const f32x4* xr = (const f32x4*)(x + (size_t)(m0 + r * mstride) * DM) + lane;
#pragma unroll
        for (int j = 0; j < 8; ++j) v[r][j] = xr[64 * j]; }
#pragma unroll
    for (int r = 0; r < R; ++r) {
        float s = 0.f;
#pragma unroll
        for (int j = 0; j < 8; ++j) s += (v[r][j].x * v[r][j].x + v[r][j].y * v[r][j].y) + (v[r][j].z * v[r][j].z + v[r][j].w * v[r][j].w);
        const float ms = wave_sum(s) * (1.f / DM) + EPS; const float rr = rsqrtf(ms);
        if (lane == 0) rinv[m0 + r * mstride] = sqrtf(ms);
        u32x2* o8 = (u32x2*)(o + (size_t)(m0 + r * mstride) * DM) + lane;
#pragma unroll
        for (int j = 0; j < 8; ++j) { u32x2 ob; ob.x = cvt_pk_bf16(v[r][j].x * rr, v[r][j].y * rr); ob.y = cvt_pk_bf16(v[r][j].z * rr, v[r][j].w * rr); o8[64 * j] = ob; }
    }
}

constexpr int H_QD = 0, H_KT = 17408, H_KDT = 34816, H_VT = 53248, H_ST = 71680, H_PP = 106496, H_SEG = 115712, H_EL = 119808;
constexpr int PITCH_T = 272;
constexpr int PITCH_S = 144;
#define MFMA16(a, b, c) __builtin_amdgcn_mfma_f32_16x16x32_bf16((a), (b), (c), 0, 0, 0)
#define HSYNC() do { asm volatile("s_waitcnt lgkmcnt(0)" ::: "memory"); __builtin_amdgcn_s_barrier(); asm volatile("" ::: "memory"); } while (0)

__device__ __forceinline__ void hgrn_unit(LAS unsigned char* lds, const bf16_t* proj, bf16_t* Y, const float* hnw, int bh) {
    const int tid = opaque_tid(), w = __builtin_amdgcn_readfirstlane(tid >> 6), lane = tid & 63, fr = lane & 15, fq = lane >> 4;
    const int b = bh >> 3, h = bh & 7;
    const unsigned* P32 = (const unsigned*)proj;
    const size_t rowbase = (size_t)b * SEQ + 8 * w;
    const int cq = (PW + h * HD) / 2 + lane, cf = (PW + HW + h * HD) / 2 + lane, cv = (PW + 2 * HW + h * HD) / 2 + lane;
    const int orow = lane >> 3, oseg = lane & 7;
    const u32x4* P128 = (const u32x4*)proj;
    const int cg16 = (PW + 3 * HW + h * HD) / 8 + 2 * oseg;
    u32x4* Y128 = (u32x4*)Y;
    const int cy16 = (PW + h * HD) / 8 + 2 * oseg;
    float nw[16];
#pragma unroll
    for (int j = 0; j < 16; ++j) nw[j] = hnw[h * HD + 16 * oseg + j];

    f32x4 S[2][4];
#pragma unroll
    for (int di = 0; di < 2; ++di)
#pragma unroll
        for (int ej = 0; ej < 4; ++ej) S[di][ej] = (f32x4){0.f, 0.f, 0.f, 0.f};
    const int dt0 = 2 * (w >> 1), et0 = 4 * (w & 1);
#pragma unroll
    for (int di = 0; di < 2; ++di)
#pragma unroll
        for (int ej = 0; ej < 4; ++ej) *(LAS u32x2*)(lds + H_ST + (16 * (et0 + ej) + fr) * PITCH_T + (16 * (dt0 + di) + 4 * fq) * 2) = (u32x2){0u, 0u};

    unsigned rq[8], rf[8], rv[8]; u32x4 rg0, rg1, ng0, ng1;
#pragma unroll
    for (int i = 0; i < 8; ++i) { const size_t r = (rowbase + i) * (INW / 2); rq[i] = P32[r + cq]; rf[i] = P32[r + cf]; rv[i] = P32[r + cv]; }
    { const size_t r = (rowbase + orow) * (INW / 8); rg0 = P128[r + cg16]; rg1 = P128[r + cg16 + 1]; }

    for (int c = 0; c < NCHUNK; ++c) {
        float kk[8][2], bl[8][2]; float cum0 = 1.f, cum1 = 1.f;
#pragma unroll
        for (int i = 0; i < 8; ++i) {
            kk[i][0] = bf_lo(rf[i]); kk[i][1] = bf_hi(rf[i]);
            cum0 *= 1.0f - kk[i][0]; cum1 *= 1.0f - kk[i][1];
            bl[i][0] = cum0; bl[i][1] = cum1;
        }
        *(LAS f32x2*)(lds + H_SEG + (w * 128 + 2 * lane) * 4) = (f32x2){cum0, cum1};
        HSYNC();
        float pre0 = 1.f, pre1 = 1.f, tot0 = 1.f, tot1 = 1.f;
#pragma unroll
        for (int ww = 0; ww < 8; ++ww) { const f32x2 sgv = *(const LAS f32x2*)(lds + H_SEG + (ww * 128 + 2 * lane) * 4); tot0 *= sgv.x; tot1 *= sgv.y; if (ww < w) { pre0 *= sgv.x; pre1 *= sgv.y; } }
        unsigned kd0[4], kd1[4], vt0[4], vt1[4];
#pragma unroll
        for (int i = 0; i < 8; ++i) {
            const float p0 = fmaxf(pre0 * bl[i][0], 1e-30f), p1 = fmaxf(pre1 * bl[i][1], 1e-30f);
            const float q0 = bf_lo(rq[i]) * p0, q1 = bf_hi(rq[i]) * p1;
            const float k0 = kk[i][0] * __builtin_amdgcn_rcpf(p0), k1 = kk[i][1] * __builtin_amdgcn_rcpf(p1);
            const float e0 = k0 * tot0, e1 = k1 * tot1;
            const int t = 8 * w + i;
            *(LAS unsigned*)(lds + H_QD + t * PITCH_T + lane * 4) = cvt_pk_bf16(q0, q1);
            *(LAS unsigned*)(lds + H_KT + t * PITCH_T + lane * 4) = cvt_pk_bf16(k0, k1);
            const unsigned ep = cvt_pk_bf16(e0, e1);
            if (i & 1) { kd0[i >> 1] |= ep << 16; kd1[i >> 1] |= ep & 0xffff0000u; vt0[i >> 1] |= rv[i] << 16; vt1[i >> 1] |= rv[i] & 0xffff0000u; }
            else { kd0[i >> 1] = ep & 0xffffu; kd1[i >> 1] = ep >> 16; vt0[i >> 1] = rv[i] & 0xffffu; vt1[i >> 1] = rv[i] >> 16; }
        }
        *(LAS u32x4*)(lds + H_KDT + (2 * lane) * PITCH_S + 16 * w) = (u32x4){kd0[0], kd0[1], kd0[2], kd0[3]};
        *(LAS u32x4*)(lds + H_KDT + (2 * lane + 1) * PITCH_S + 16 * w) = (u32x4){kd1[0], kd1[1], kd1[2], kd1[3]};
        *(LAS u32x4*)(lds + H_VT + (2 * lane) * PITCH_S + 16 * w) = (u32x4){vt0[0], vt0[1], vt0[2], vt0[3]};
        *(LAS u32x4*)(lds + H_VT + (2 * lane + 1) * PITCH_S + 16 * w) = (u32x4){vt1[0], vt1[1], vt1[2], vt1[3]};
        if (w == 0) *(LAS f32x2*)(lds + H_EL + lane * 8) = (f32x2){tot0, tot1};
        if (c + 1 < NCHUNK) {
#pragma unroll
            for (int i = 0; i < 8; ++i) { const size_t r = (rowbase + (size_t)(c + 1) * CHUNK + i) * (INW / 2); rq[i] = P32[r + cq]; rf[i] = P32[r + cf]; rv[i] = P32[r + cv]; }
            const size_t r = (rowbase + (size_t)(c + 1) * CHUNK + orow) * (INW / 8); ng0 = P128[r + cg16]; ng1 = P128[r + cg16 + 1];
        }
        HSYNC();
        {
            const int si = w >> 1;
#pragma unroll
            for (int tt = 0; tt < 2; ++tt) {
                const int ti = 2 * (w & 1) + tt;
                f32x4 a = (f32x4){0.f, 0.f, 0.f, 0.f};
                if (si <= ti) {
#pragma unroll
                    for (int ks = 0; ks < 4; ++ks) {
                        const bf16x8 A = *(const LAS bf16x8*)(lds + H_KT + (16 * si + fr) * PITCH_T + (8 * fq + 32 * ks) * 2);
                        const bf16x8 B = *(const LAS bf16x8*)(lds + H_QD + (16 * ti + fr) * PITCH_T + (8 * fq + 32 * ks) * 2);
                        a = MFMA16(A, B, a);
                    }
                    if (si == ti) {
#pragma unroll
                        for (int r = 0; r < 4; ++r) if (4 * fq + r > fr) a[r] = 0.f;
                    }
                }
                *(LAS u32x2*)(lds + H_PP + (16 * ti + fr) * PITCH_S + (16 * si + 4 * fq) * 2) = (u32x2){cvt_pk_bf16(a[0], a[1]), cvt_pk_bf16(a[2], a[3])};
            }
        }
        HSYNC();
        {
            f32x4 o[4];
#pragma unroll
            for (int ti = 0; ti < 4; ++ti) o[ti] = (f32x4){0.f, 0.f, 0.f, 0.f};
#pragma unroll
            for (int ks = 0; ks < 4; ++ks) {
                const bf16x8 A = *(const LAS bf16x8*)(lds + H_ST + (16 * w + fr) * PITCH_T + (8 * fq + 32 * ks) * 2);
#pragma unroll
                for (int ti = 0; ti < 4; ++ti) { const bf16x8 B = *(const LAS bf16x8*)(lds + H_QD + (16 * ti + fr) * PITCH_T + (8 * fq + 32 * ks) * 2); o[ti] = MFMA16(A, B, o[ti]); }
            }
#pragma unroll
            for (int ks = 0; ks < 2; ++ks) {
                const bf16x8 A = *(const LAS bf16x8*)(lds + H_VT + (16 * w + fr) * PITCH_S + (8 * fq + 32 * ks) * 2);
#pragma unroll
                for (int ti = 0; ti < 4; ++ti) { const bf16x8 B = *(const LAS bf16x8*)(lds + H_PP + (16 * ti + fr) * PITCH_S + (8 * fq + 32 * ks) * 2); o[ti] = MFMA16(A, B, o[ti]); }
            }
#pragma unroll
            for (int ti = 0; ti < 4; ++ti) *(LAS u32x2*)(lds + H_KT + (16 * ti + fr) * PITCH_T + (16 * w + 4 * fq) * 2) = (u32x2){cvt_pk_bf16(o[ti][0], o[ti][1]), cvt_pk_bf16(o[ti][2], o[ti][3])};
        }
        {
#pragma unroll
            for (int di = 0; di < 2; ++di) {
                const f32x4 el = *(const LAS f32x4*)(lds + H_EL + (16 * (dt0 + di) + 4 * fq) * 4);
#pragma unroll
                for (int ej = 0; ej < 4; ++ej) S[di][ej] = S[di][ej] * el;
            }
#pragma unroll
            for (int ks = 0; ks < 2; ++ks) {
                bf16x8 A[2], B[4];
#pragma unroll
                for (int di = 0; di < 2; ++di) A[di] = *(const LAS bf16x8*)(lds + H_KDT + (16 * (dt0 + di) + fr) * PITCH_S + (8 * fq + 32 * ks) * 2);
#pragma unroll
                for (int ej = 0; ej < 4; ++ej) B[ej] = *(const LAS bf16x8*)(lds + H_VT + (16 * (et0 + ej) + fr) * PITCH_S + (8 * fq + 32 * ks) * 2);
#pragma unroll
                for (int di = 0; di < 2; ++di)
#pragma unroll
                    for (int ej = 0; ej < 4; ++ej) S[di][ej] = MFMA16(A[di], B[ej], S[di][ej]);
            }
        }
        HSYNC();
#pragma unroll
        for (int di = 0; di < 2; ++di)
#pragma unroll
            for (int ej = 0; ej < 4; ++ej)
                *(LAS u32x2*)(lds + H_ST + (16 * (et0 + ej) + fr) * PITCH_T + (16 * (dt0 + di) + 4 * fq) * 2) = (u32x2){cvt_pk_bf16(S[di][ej][0], S[di][ej][1]), cvt_pk_bf16(S[di][ej][2], S[di][ej][3])};
        {
            const u32x4 oa = *(const LAS u32x4*)(lds + H_KT + (8 * w + orow) * PITCH_T + oseg * 32);
            const u32x4 ob = *(const LAS u32x4*)(lds + H_KT + (8 * w + orow) * PITCH_T + oseg * 32 + 16);
            const unsigned ou[8] = {oa.x, oa.y, oa.z, oa.w, ob.x, ob.y, ob.z, ob.w};
            const unsigned gu[8] = {rg0.x, rg0.y, rg0.z, rg0.w, rg1.x, rg1.y, rg1.z, rg1.w};
            float gv[16]; float ssq = 0.f;
#pragma unroll
            for (int j = 0; j < 8; ++j) { gv[2 * j] = bf_lo(ou[j]) * bf_lo(gu[j]); gv[2 * j + 1] = bf_hi(ou[j]) * bf_hi(gu[j]); ssq += gv[2 * j] * gv[2 * j] + gv[2 * j + 1] * gv[2 * j + 1]; }
            ssq += __shfl_xor(ssq, 1); ssq += __shfl_xor(ssq, 2); ssq += __shfl_xor(ssq, 4);
            const float r = rsqrtf(ssq * (1.0f / HD) + EPS);
            u32x4 y0, y1;
            y0.x = cvt_pk_bf16(gv[0] * r * nw[0], gv[1] * r * nw[1]); y0.y = cvt_pk_bf16(gv[2] * r * nw[2], gv[3] * r * nw[3]);
            y0.z = cvt_pk_bf16(gv[4] * r * nw[4], gv[5] * r * nw[5]); y0.w = cvt_pk_bf16(gv[6] * r * nw[6], gv[7] * r * nw[7]);
            y1.x = cvt_pk_bf16(gv[8] * r * nw[8], gv[9] * r * nw[9]); y1.y = cvt_pk_bf16(gv[10] * r * nw[10], gv[11] * r * nw[11]);
            y1.z = cvt_pk_bf16(gv[12] * r * nw[12], gv[13] * r * nw[13]); y1.w = cvt_pk_bf16(gv[14] * r * nw[14], gv[15] * r * nw[15]);
            const size_t yr = (rowbase + (size_t)c * CHUNK + orow) * (DM / 8);
            Y128[yr + cy16] = y0; Y128[yr + cy16 + 1] = y1;
        }
        rg0 = ng0; rg1 = ng1;
    }
    __syncthreads();
}

__device__ __forceinline__ void pool_diff_unit(const bf16_t* proj, bf16_t* D, int unit) {
    const int tid = opaque_tid(), tq = tid >> 7, cgp = tid & 127;
    const int b = unit >> 5, tc = unit & 31;
    const int j = cgp >> 5, win = 2 << j;
    const int t0 = tc * 64 + tq * 16;
    const u32x4* P = (const u32x4*)proj + (size_t)b * SEQ * (INW / 8) + cgp;
    u32x4 row[32];
#pragma unroll
    for (int r = 0; r < 32; ++r) { const int t = t0 - 16 + r; row[r] = (t >= 0) ? P[(size_t)t * (INW / 8)] : (u32x4){0u, 0u, 0u, 0u}; }
    float sum[8];
#pragma unroll
    for (int e = 0; e < 8; ++e) sum[e] = 0.f;
#pragma unroll
    for (int k = 1; k <= 16; ++k) {
        const float mk = (k <= win) ? 1.f : 0.f; const u32x4 v = row[16 - k];
        sum[0] += mk * bf_lo(v.x); sum[1] += mk * bf_hi(v.x); sum[2] += mk * bf_lo(v.y); sum[3] += mk * bf_hi(v.y);
        sum[4] += mk * bf_lo(v.z); sum[5] += mk * bf_hi(v.z); sum[6] += mk * bf_lo(v.w); sum[7] += mk * bf_hi(v.w);
    }
    const float invw = (j == 0) ? 0.5f : (j == 1) ? 0.25f : (j == 2) ? 0.125f : 0.0625f;
    u32x4* Dp = (u32x4*)D + ((size_t)b * SEQ + t0) * (PW / 8) + cgp;
#pragma unroll
    for (int i = 0; i < 16; ++i) {
        const u32x4 v = row[16 + i];
        const u32x4 a = row[16 + i - 2], bq = row[16 + i - 4], cq = row[16 + i - 8], dq = row[i];
        u32x4 o;
        o.x = (j == 0) ? a.x : (j == 1) ? bq.x : (j == 2) ? cq.x : dq.x; o.y = (j == 0) ? a.y : (j == 1) ? bq.y : (j == 2) ? cq.y : dq.y;
        o.z = (j == 0) ? a.z : (j == 1) ? bq.z : (j == 2) ? cq.z : dq.z; o.w = (j == 0) ? a.w : (j == 1) ? bq.w : (j == 2) ? cq.w : dq.w;
        const float u[8] = {bf_lo(v.x), bf_hi(v.x), bf_lo(v.y), bf_hi(v.y), bf_lo(v.z), bf_hi(v.z), bf_lo(v.w), bf_hi(v.w)};
        const float ov[8] = {bf_lo(o.x), bf_hi(o.x), bf_lo(o.y), bf_hi(o.y), bf_lo(o.z), bf_hi(o.z), bf_lo(o.w), bf_hi(o.w)};
#pragma unroll
        for (int e = 0; e < 8; ++e) sum[e] += u[e] - ov[e];
        const int t = t0 + i;
        const float inv = (t + 1 >= win) ? invw : __builtin_amdgcn_rcpf((float)(t + 1));
        u32x4 d; d.x = cvt_pk_bf16(sum[0] * inv - u[0], sum[1] * inv - u[1]); d.y = cvt_pk_bf16(sum[2] * inv - u[2], sum[3] * inv - u[3]);
        d.z = cvt_pk_bf16(sum[4] * inv - u[4], sum[5] * inv - u[5]); d.w = cvt_pk_bf16(sum[6] * inv - u[6], sum[7] * inv - u[7]);
        Dp[(size_t)i * (PW / 8)] = d;
    }
}

#define XB_TMO      128
#define XB_XCNT(j)  (256  + 64 * (j))
#define XB_XSUB(j)  (1280 + 64 * (j))
#define XB_XGEN(j)  (2304 + 64 * (j))
#define XB_TOP      3328
#define XB_TOPGEN   3392
#define XCD_BAR_WORDS 3456
#define XB_SPIN_CAP (1u << 18)

__device__ __forceinline__ unsigned xb_ld(unsigned* p)              { return __hip_atomic_load(p, __ATOMIC_RELAXED, __HIP_MEMORY_SCOPE_AGENT); }
__device__ __forceinline__ unsigned xb_add(unsigned* p, unsigned v) { return __hip_atomic_fetch_add(p, v, __ATOMIC_RELAXED, __HIP_MEMORY_SCOPE_AGENT); }
__device__ __forceinline__ unsigned xb_xcc_id() { return (unsigned)__builtin_amdgcn_s_getreg((3 << 11) | 20) & 0xFu; }
#define XB_SPIN(cond, bar) do { unsigned _sp = 0; while (cond) { __builtin_amdgcn_s_sleep(1); \
    if ((++_sp & 255u) == 0u) { if (xb_ld(&(bar)[XB_TMO])) break; if (_sp > XB_SPIN_CAP) { atomicAdd(&(bar)[XB_TMO], 1u); break; } } } } while (0)

struct XcdBarrier {
    unsigned* bar; unsigned x;
    volatile LAS unsigned* st;
};

__device__ __forceinline__ XcdBarrier xcd_barrier_post(unsigned* bar, volatile LAS unsigned* st) {
    XcdBarrier b; b.bar = bar; b.x = xb_xcc_id(); b.st = st;
    if (threadIdx.x == 0) (void)xb_add(&bar[XB_XCNT(b.x)], 1u);
    return b;
}
__device__ __forceinline__ void xcd_barrier_complete(unsigned* bar, unsigned x, unsigned& nloc, unsigned& nx) {
    const unsigned G = gridDim.x * gridDim.y * gridDim.z;
    unsigned sum, cnt, mine, sp = 0u;
    for (;;) {
        sum = 0u; cnt = 0u; mine = 0u;
#pragma unroll
        for (unsigned j = 0; j < 16; ++j) { const unsigned c = xb_ld(&bar[XB_XCNT(j)]); sum += c; cnt += (c > 0u) ? 1u : 0u; mine = (j == x) ? c : mine; }
        if (sum == G) break;
        __builtin_amdgcn_s_sleep(1);
        if ((++sp & 255u) == 0u) { if (xb_ld(&bar[XB_TMO])) break; if (sp > XB_SPIN_CAP) { atomicAdd(&bar[XB_TMO], 1u); break; } }
    }
    nloc = mine > 0u ? mine : 1u; nx = cnt > 0u ? cnt : 1u;
}

__device__ __forceinline__ void xcd_barrier(const XcdBarrier& b) {
    asm volatile("s_waitcnt vmcnt(0)" ::: "memory");
    __syncthreads();
    if (threadIdx.x == 0) {
        unsigned* bar = b.bar;
        __builtin_amdgcn_s_waitcnt(0);
        unsigned nloc = b.st[0], nx = b.st[1];
        if (nloc == 0u) { xcd_barrier_complete(bar, b.x, nloc, nx); b.st[0] = nloc; b.st[1] = nx; }
        const unsigned old = xb_add(&bar[XB_XSUB(b.x)], 1u);
        const unsigned gen = old / nloc;
        if (old + 1u == (gen + 1u) * nloc) {
            __builtin_amdgcn_fence(__ATOMIC_RELEASE, "agent");
            asm volatile("s_waitcnt vmcnt(0)" ::: "memory");
            const unsigned og = xb_add(&bar[XB_TOP], 1u);
            const unsigned tg = og / nx;
            if (og + 1u == (tg + 1u) * nx) xb_add(&bar[XB_TOPGEN], 1u);
            else XB_SPIN(xb_ld(&bar[XB_TOPGEN]) == tg, bar);
            __builtin_amdgcn_fence(__ATOMIC_ACQUIRE, "agent");
            xb_add(&bar[XB_XGEN(b.x)], 1u);
            asm volatile("s_waitcnt vmcnt(0)" ::: "memory");
        } else {
            XB_SPIN(xb_ld(&bar[XB_XGEN(b.x)]) == gen, bar);
            __builtin_amdgcn_fence(__ATOMIC_ACQUIRE, "agent");
            asm volatile("s_waitcnt vmcnt(0)" ::: "memory");
        }
    }
    __syncthreads();
}

__device__ __forceinline__ void grid_barrier(cg::grid_group& grid) {
    asm volatile("s_waitcnt vmcnt(0)" ::: "memory");
    grid.sync();
    __builtin_amdgcn_fence(__ATOMIC_ACQUIRE, "agent");
    asm volatile("s_waitcnt vmcnt(0)" ::: "memory");
}


#ifdef DBG_STOP
#define DBG_DUMP(k, SRC, LD, COFF) if (DBG_STOP == (k)) { for (int m = gw; m < M; m += NGW) { const unsigned* sr = (const unsigned*)((SRC) + (size_t)m * (LD) + (COFF)); float* orow = p.out + (size_t)m * DM; \
        for (int j = lane; j < DM / 2; j += 64) { const unsigned v = sr[j]; orow[2 * j] = bf_lo(v); orow[2 * j + 1] = bf_hi(v); } } return; }
#else
#define DBG_DUMP(k, SRC, LD, COFF)
#endif

__device__ __forceinline__ void xcd_stagger() { const int cls = blockIdx.x & 7; for (int i = 0; i < cls; ++i) __builtin_amdgcn_s_sleep(127); }

struct Params {
    const float* x; const float* w_in; const float* pool_w; const float* pool_b; const float* pool_scale;
    const float* lb_logits; const float* hgrn_norm_w; const float* w_out;
    const float* n_mix_pre; const float* n_mix_post; const float* n_mlp_pre; const float* n_mlp_post;
    const float* w_mlp_in; const float* w_mlp_out;
    float* out; unsigned char* ws;
};

__global__ void __launch_bounds__(NTHREADS, 2) fwd_megakernel(Params p) {
    extern __shared__ __attribute__((aligned(16))) unsigned char lds_raw[];
    LAS unsigned char* lds = (LAS unsigned char*)lds_raw;
    cg::grid_group grid = cg::this_grid();
    const int G = gridDim.x, bx = blockIdx.x;
    volatile LAS unsigned* xb_st = (volatile LAS unsigned*)(lds + 131072 + 256);
    if (threadIdx.x < 2) xb_st[threadIdx.x] = 0u;
    __syncthreads();
    const XcdBarrier xbar = xcd_barrier_post((unsigned*)(p.ws + WS_BAR), xb_st);
#define SEAM() xcd_barrier(xbar)
    if (G == 0x7fffffff) grid_barrier(grid);
    const int NGW = G * NWAVES;
    unsigned char* ws = p.ws;
    bf16_t* Win_t = (bf16_t*)(ws + WS_WIN); bf16_t* Wout_t = (bf16_t*)(ws + WS_WOUT); bf16_t* W1_t = (bf16_t*)(ws + WS_W1); bf16_t* W2_t = (bf16_t*)(ws + WS_W2);
    bf16_t* Wpool_t = (bf16_t*)(ws + WS_WPOOL);
    float* SS1 = (float*)(ws + WS_SS1); float* SS2 = (float*)(ws + WS_SS2);
    bf16_t* HN = (bf16_t*)(ws + WS_HN); bf16_t* MIX = (bf16_t*)(ws + WS_MIX); bf16_t* DD = (bf16_t*)(ws + WS_D);
    bf16_t* PROJ = (bf16_t*)(ws + WS_PROJ); bf16_t* FFH = (bf16_t*)(ws + WS_FFH);
    float* R2 = (float*)(ws + WS_R2); float* RINV = (float*)(ws + WS_RINV); bf16_t* YB = (bf16_t*)(ws + WS_Y);
    bf16_t* X1B = MIX;
    unsigned* SSB1 = (unsigned*)(ws + WS_SS1); unsigned* SSB1B = (unsigned*)(ws + WS_SS1 + 2 * MiB); unsigned* SSB2 = (unsigned*)(ws + WS_SS2);
    unsigned* CNT_A = (unsigned*)(ws + 131072); unsigned* CNT_B = CNT_A + 128 * 16; unsigned* CNT_C = CNT_B + 128 * 16;
    unsigned* qctr = (unsigned*)ws;

#ifndef PHMASK
#define PHMASK 0x1ff
#endif
#if (PHMASK>>0)&1
    {
        const int tid = opaque_tid(), lane = tid & 63, wave = __builtin_amdgcn_readfirstlane(tid >> 6), gw = bx * NWAVES + wave;
        if (bx == 0 && tid == 0) __hip_atomic_store(qctr, 0u, __ATOMIC_RELAXED, __HIP_MEMORY_SCOPE_AGENT);
        LAS float* scr = (LAS float*)(lds + wave * 16384);
        constexpr int I_IN = (DM / 64) * (INW / 32), I_P = (256 / 64) * (256 / 32);
        constexpr int NITEMS = I_IN + 4 * I_P;
        for (int it = gw; it < NITEMS; it += NGW) {
            int r = it;
            if (r < I_IN) { p0_transpose_item(p.w_in, DM, INW, Win_t, scr, r, lane, nullptr, p.n_mix_pre); continue; } r -= I_IN;
            const int j = r / I_P; r -= j * I_P;
            p0_transpose_item(p.pool_w + (size_t)j * 256 * 256, 256, 256, Wpool_t + (size_t)j * 256 * 256, scr, r, lane, p.pool_scale + j * 256);
        }
        {
            int m = gw;
            for (; m + 3 * NGW < M; m += 4 * NGW) rms_rows_to_bf16<4>(p.x, RINV, HN, m, NGW, lane);
            for (; m < M; m += NGW) rms_rows_to_bf16<1>(p.x, RINV, HN, m, NGW, lane);
        }
    }
    SEAM();

#endif
#if (PHMASK>>1)&1
    {
        pg8::Gemm g{HN, Win_t, DM, DM, DM, 0}; pg8::StaticOrder S; S.init(M, INW, G, bx);
        pg8::Epi<4> E{PROJ, INW, p.lb_logits, nullptr, nullptr};
        xcd_stagger();
        pg8::gemm_phase(lds, g, S, E);
    }
    SEAM();
    DBG_DUMP(1, PROJ, INW, 1024)
#endif
#if (PHMASK>>2)&1
    {
        const int NH = (G / 2 < NB * NHEAD) ? G / 2 : NB * NHEAD;
        if (bx < NH) {
            for (int u = bx; u < NB * NHEAD; u += NH) hgrn_unit(lds, PROJ, YB, p.hgrn_norm_w, u);
        } else {
            const int NP = G - NH, pb = bx - NH;
            for (int pm = pb; pm < M / 256; pm += NP)
                for (int k = 0; k < 4; ++k) pool_diff_unit(PROJ, DD, pm * 4 + k);
            __threadfence(); __builtin_amdgcn_fence(__ATOMIC_ACQUIRE, "agent"); __syncthreads();
            {
                pg8::Gemm g{DD, Wpool_t, PW, 256, 256, 512}; pg8::PanelOrder S{pb, NP, M / 256};
                pg8::Epi<2> E{YB, DM, p.pool_b, p.pool_scale, nullptr};
                pg8::gemm_phase(lds, g, S, E);
            }
        }
        {
            const int tid = opaque_tid(), lane = tid & 63, wave = __builtin_amdgcn_readfirstlane(tid >> 6);
            LAS float* scr = (LAS float*)(lds + wave * 16384);
            constexpr int I_OUT = (DM / 64) * (DM / 32), I_1 = (DM / 64) * (FFW / 32), I_2 = (FFW / 64) * (DM / 32);
            constexpr int QB = 8;
            for (;;) {
                int base = 0;
                if (lane == 0) base = (int)__hip_atomic_fetch_add(qctr, (unsigned)QB, __ATOMIC_RELAXED, __HIP_MEMORY_SCOPE_AGENT);
                base = __builtin_amdgcn_readfirstlane(base);
                if (base >= I_OUT + I_1 + I_2) break;
                for (int it = base; it < base + QB && it < I_OUT + I_1 + I_2; ++it) {
                    int r = it;
                    if (r < I_OUT) { p0_transpose_item(p.w_out, DM, DM, Wout_t, scr, r, lane); continue; } r -= I_OUT;
                    if (r < I_1) { p0_transpose_item(p.w_mlp_in, DM, FFW, W1_t, scr, r, lane, nullptr, p.n_mlp_pre); continue; } r -= I_1;
                    p0_transpose_item(p.w_mlp_out, FFW, DM, W2_t, scr, r, lane);
                }
            }
        }
    }
    SEAM();

#endif
#if (PHMASK>>4)&1
    {
        pg8::Gemm g{YB, Wout_t, DM, DM, DM, 0}; pg8::FusedOrder S{bx, G, M / 256};
        pg8::EpiFused<5> E{nullptr, HN, X1B, nullptr, p.n_mix_post, SSB1, CNT_A, SSB1B, CNT_B, R2, RINV};
        pg8::gemm_phase(lds, g, S, E);
    }
    SEAM();
#endif
#if (PHMASK>>5)&1
#endif
#if (PHMASK>>6)&1
    {
        pg8::Gemm g{X1B, W1_t, DM, DM, DM, 0}; pg8::StaticOrder S; S.init(M, FFW, G, bx);
        pg8::Epi<1> E{FFH, FFW, nullptr, R2, nullptr};
        xcd_stagger();
        pg8::gemm_phase(lds, g, S, E);
    }
    SEAM();
    DBG_DUMP(6, FFH, FFW, 0)
#endif
#if (PHMASK>>7)&1
    {
        pg8::Gemm g{FFH, W2_t, FFW, FFW, FFW, 0}; pg8::FusedOrder S{bx, G, M / 256};
        pg8::EpiFused<6> E{nullptr, X1B, nullptr, p.out, p.n_mlp_post, SSB2, CNT_C, nullptr, nullptr, nullptr, nullptr};
        pg8::gemm_phase(lds, g, S, E);
    }
#endif
}

extern "C" void kernel_launch(void* const* d_in, const int* in_sizes, int n_in, void* d_out, int out_size, void* d_ws, size_t ws_size, hipStream_t stream) {
    static int grid_blocks = 0;
    if (grid_blocks == 0) {
        if (n_in != 14 || in_sizes[0] != M * DM || out_size != M * DM || ws_size < WS_END) { fprintf(stderr, "kernel_launch: unexpected shapes (n_in %d, in0 %d, out %d, ws %zu)\n", n_in, n_in > 0 ? in_sizes[0] : -1, out_size, ws_size); grid_blocks = -1; return; }
        int dev = 0, cus = 0, per_cu = 0;
        hipGetDevice(&dev);
        hipDeviceGetAttribute(&cus, hipDeviceAttributeMultiprocessorCount, dev);
        if (hipFuncSetAttribute((const void*)fwd_megakernel, hipFuncAttributeMaxDynamicSharedMemorySize, LDS_BYTES) != hipSuccess) { fprintf(stderr, "kernel_launch: hipFuncSetAttribute failed\n"); grid_blocks = -1; return; }
        if (hipOccupancyMaxActiveBlocksPerMultiprocessor(&per_cu, (const void*)fwd_megakernel, NTHREADS, LDS_BYTES) != hipSuccess || per_cu < 1) { fprintf(stderr, "kernel_launch: occupancy query says %d\n", per_cu); per_cu = 1; }
        (void)hipGetLastError();
        if (per_cu > 1) per_cu = 1;
        grid_blocks = cus * per_cu;
    }
    if (grid_blocks < 0) return;
    Params p{};
    p.x = (const float*)d_in[0]; p.w_in = (const float*)d_in[1]; p.pool_w = (const float*)d_in[2]; p.pool_b = (const float*)d_in[3]; p.pool_scale = (const float*)d_in[4];
    p.lb_logits = (const float*)d_in[5]; p.hgrn_norm_w = (const float*)d_in[6]; p.w_out = (const float*)d_in[7];
    p.n_mix_pre = (const float*)d_in[8]; p.n_mix_post = (const float*)d_in[9]; p.n_mlp_pre = (const float*)d_in[10]; p.n_mlp_post = (const float*)d_in[11];
    p.w_mlp_in = (const float*)d_in[12]; p.w_mlp_out = (const float*)d_in[13];
    p.out = (float*)d_out; p.ws = (unsigned char*)d_ws;
    if (hipMemsetAsync(d_ws, 0, 1u << 20, stream) != hipSuccess) { fprintf(stderr, "kernel_launch: hipMemsetAsync failed\n"); return; }
    void* args[] = {&p};
    hipError_t e = hipLaunchCooperativeKernel((const void*)fwd_megakernel, dim3(grid_blocks), dim3(NTHREADS), args, LDS_BYTES, stream);
    if (e != hipSuccess) fprintf(stderr, "cooperative launch failed: %s (grid %d)\n", hipGetErrorString(e), grid_blocks);
}
```

```cpp
#include <hip/hip_runtime.h>
#include <hip/hip_cooperative_groups.h>
#include <cstdio>
#include <cstdint>
namespace cg = cooperative_groups;

#define LAS __attribute__((address_space(3)))
typedef unsigned short bf16_t;
typedef short bf16x8 __attribute__((ext_vector_type(8)));
typedef float f32x4 __attribute__((ext_vector_type(4)));
typedef float f32x2 __attribute__((ext_vector_type(2)));
typedef unsigned u32x4 __attribute__((ext_vector_type(4)));
typedef unsigned u32x2 __attribute__((ext_vector_type(2)));

constexpr int NB = 16, SEQ = 2048, DM = 2048, M = NB * SEQ;
constexpr int PW = 1024, HW = 1024, INW = PW + 4 * HW, FFW = 4 * DM, NHEAD = 8, HD = 128, CHUNK = 64, NCHUNK = SEQ / CHUNK;
constexpr float EPS = 1e-6f;
constexpr int NTHREADS = 512, NWAVES = 8;
constexpr int LDS_BYTES = 138 * 1024;
constexpr int XCH_OFF = 131072 + 512;

constexpr size_t MiB = 1u << 20;
constexpr size_t WS_WIN = 2 * MiB, WS_WOUT = 22 * MiB, WS_W1 = 30 * MiB, WS_W2 = 62 * MiB, WS_WPOOL = 94 * MiB;
constexpr size_t WS_SS1 = 96 * MiB, WS_SS2 = 100 * MiB;
constexpr size_t WS_BAR = 65536;
constexpr size_t WS_Y = 744 * MiB;
constexpr size_t WS_RINV = 95 * MiB + 512 * 1024;
constexpr size_t WS_R2 = 95 * MiB;
constexpr size_t WS_HN = 104 * MiB;
constexpr size_t WS_MIX = 232 * MiB;
constexpr size_t WS_D = 360 * MiB;
constexpr size_t WS_PROJ = 424 * MiB;
constexpr size_t WS_FFH = 424 * MiB;
constexpr size_t WS_END = 936 * MiB;

typedef __bf16 bf16x2_t __attribute__((ext_vector_type(2)));
__device__ __forceinline__ unsigned cvt_pk_bf16(float lo, float hi) { f32x2 v = {lo, hi}; bf16x2_t b = __builtin_convertvector(v, bf16x2_t); return __builtin_bit_cast(unsigned, b); }
__device__ __forceinline__ float bf_lo(unsigned u) { return __builtin_bit_cast(float, u << 16); }
__device__ __forceinline__ float bf_hi(unsigned u) { return __builtin_bit_cast(float, u & 0xffff0000u); }
__device__ __forceinline__ float wave_sum(float v) {
#pragma unroll
    for (int o = 1; o < 64; o <<= 1) v += __shfl_xor(v, o);
    return v;
}
__device__ __forceinline__ float sigmoidf_(float x) { return __builtin_amdgcn_rcpf(1.0f + __expf(-x)); }
#define LDS_WAIT() asm volatile("s_waitcnt lgkmcnt(0)" ::: "memory")
__device__ __forceinline__ int opaque_tid() { int t = threadIdx.x; asm volatile("" : "+v"(t)); return t; }

namespace pg8 {
constexpr int BM = 256, BK = 64, HALF = 128, HTB = HALF * BK * 2, STAGE_BYTES = 8 * HTB, NXCD = 8, WGM = 8;
__host__ __device__ __forceinline__ int lds_byte(int r, int c) { const int st = (r >> 4) * 2 + (c >> 5), rr = r & 15, cc = c & 31, ob = rr * 64 + cc * 2; return st * 1024 + (ob ^ (((ob >> 9) & 1) << 5)); }
__host__ __device__ __forceinline__ void stage_rc(int b, int& R, int& C) { const int st = b / 1024, sb = b % 1024, swz = sb ^ (((sb >> 9) & 1) << 5); R = (st >> 1) * 16 + swz / 64; C = (st & 1) * 32 + (swz % 64) / 2; }
__host__ __device__ __forceinline__ int perm32(int rho) { const int n = rho >> 4, i = rho & 15; return 8 * (i >> 2) + 4 * n + (i & 3); }

struct Unit { int pm, pn; };
struct Gemm { const bf16_t* A; const bf16_t* Bt; int lda, ldb, K, a_pn_bytes; };

struct StaticOrder {
    int nM, nN, nwg, G, c;
    __device__ void init(int M_, int N_, int G_, int c_) { nM = M_ / BM; nN = N_ / BM; nwg = nM * nN; G = G_; c = c_; }
    __device__ bool next(int i, Unit& u) const {
        const long L = (long)i * G + c; if (L >= nwg) return false;
        int wgid = (int)L; { const int q = nwg / NXCD, r = nwg % NXCD, xcd = wgid % NXCD, off = wgid / NXCD; wgid = (xcd < r ? xcd * (q + 1) : r * (q + 1) + (xcd - r) * q) + off; }
        const int nig = WGM * nN, gid = wgid / nig, fm = gid * WGM, gsz = (nM - fm) < WGM ? (nM - fm) : WGM;
        u.pm = fm + ((wgid % nig) % gsz); u.pn = (wgid % nig) / gsz; return true;
    }
};

struct PanelOrder {
    int pb, NP, nM;
    __device__ bool next(int i, Unit& u) const { const int pm = pb + (i >> 2) * NP; if (pm >= nM) return false; u.pm = pm; u.pn = i & 3; return true; }
};

template <int MODE> struct Epi {
    static constexpr bool FUSED = false;
    bf16_t* O; int ldc; const float* bias; const float* scale; float* ss;
    __device__ __forceinline__ void operator()(const f32x4 (&acc)[2][2][4][2], const Unit& u, int wr, int wc, int fr, int fq) const {
        const int row0 = u.pm * BM + wr * 64 + fr; const int col0 = u.pn * BM + wc * 32 + 8 * fq;
        if (MODE == 4) {
            const int kind = u.pn >> 2;
#pragma unroll
            for (int bj = 0; bj < 2; ++bj) {
                float om[8];
                if (kind == 2) {
                    const int hc = col0 + bj * HALF - (PW + HW);
#pragma unroll
                    for (int e = 0; e < 8; ++e) om[e] = __builtin_amdgcn_rcpf(1.0f + __expf(bias[hc + e] - bias[HW + hc + e]));
                }
#pragma unroll
                for (int ai = 0; ai < 2; ++ai)
#pragma unroll
                    for (int m = 0; m < 4; ++m) {
                        const int row = row0 + ai * HALF + m * 16;
                        f32x4 v0 = acc[ai][bj][m][0], v1 = acc[ai][bj][m][1];
                        if (kind == 2) {
#pragma unroll
                            for (int e = 0; e < 4; ++e) { v0[e] = om[e] * __builtin_amdgcn_rcpf(1.0f + __expf(v0[e])); v1[e] = om[4 + e] * __builtin_amdgcn_rcpf(1.0f + __expf(v1[e])); }
                        } else if (kind == 4) {
#pragma unroll
                            for (int e = 0; e < 4; ++e) { v0[e] = __builtin_amdgcn_rcpf(1.0f + __expf(-v0[e])); v1[e] = __builtin_amdgcn_rcpf(1.0f + __expf(-v1[e])); }
                        }
                        u32x4 w; w.x = cvt_pk_bf16(v0[0], v0[1]); w.y = cvt_pk_bf16(v0[2], v0[3]); w.z = cvt_pk_bf16(v1[0], v1[1]); w.w = cvt_pk_bf16(v1[2], v1[3]);
                        *(u32x4*)(O + (size_t)row * ldc + col0 + bj * HALF) = w;
                    }
            }
            return;
        }
        if (MODE == 2) {
#pragma unroll
            for (int bj = 0; bj < 2; ++bj) {
                const f32x4 b0 = *(const f32x4*)(bias + col0 + bj * HALF) * *(const f32x4*)(scale + col0 + bj * HALF);
                const f32x4 b1 = *(const f32x4*)(bias + col0 + bj * HALF + 4) * *(const f32x4*)(scale + col0 + bj * HALF + 4);
#pragma unroll
                for (int ai = 0; ai < 2; ++ai)
#pragma unroll
                    for (int m = 0; m < 4; ++m) {
                        const int row = row0 + ai * HALF + m * 16;
                        const f32x4 v0 = acc[ai][bj][m][0] + b0, v1 = acc[ai][bj][m][1] + b1;
                        u32x4 w; w.x = cvt_pk_bf16(v0[0], v0[1]); w.y = cvt_pk_bf16(v0[2], v0[3]); w.z = cvt_pk_bf16(v1[0], v1[1]); w.w = cvt_pk_bf16(v1[2], v1[3]);
                        *(u32x4*)(O + (size_t)row * ldc + col0 + bj * HALF) = w;
                    }
            }
            return;
        }
#pragma unroll
        for (int ai = 0; ai < 2; ++ai)
#pragma unroll
            for (int m = 0; m < 4; ++m) {
                const int row = row0 + ai * HALF + m * 16;
                bf16_t* rowp = O + (size_t)row * ldc + col0; float s = 0.f;
                const float rsc = (MODE == 1) ? scale[row] : 1.0f;
#pragma unroll
                for (int bj = 0; bj < 2; ++bj) {
                    f32x4 v0 = acc[ai][bj][m][0], v1 = acc[ai][bj][m][1];
                    if (MODE == 1) {
#pragma unroll
                        for (int e = 0; e < 4; ++e) { float a = fmaxf(v0[e] * rsc, 0.f), b = fmaxf(v1[e] * rsc, 0.f); v0[e] = a * a; v1[e] = b * b; }
                    }
                    if (MODE == 3) { s += (v0[0] * v0[0] + v0[1] * v0[1]) + (v0[2] * v0[2] + v0[3] * v0[3]) + (v1[0] * v1[0] + v1[1] * v1[1]) + (v1[2] * v1[2] + v1[3] * v1[3]); }
                    u32x4 w; w.x = cvt_pk_bf16(v0[0], v0[1]); w.y = cvt_pk_bf16(v0[2], v0[3]); w.z = cvt_pk_bf16(v1[0], v1[1]); w.w = cvt_pk_bf16(v1[2], v1[3]);
                    *(u32x4*)(rowp + bj * HALF) = w;
                }
                if (MODE == 3) { s += __shfl_xor(s, 16); s += __shfl_xor(s, 32); if (fq == 0) ss[(size_t)row * 32 + u.pn * 4 + wc] = s; }
            }
    }
};

struct FusedOrder {
    int c, G, nM;
    __device__ bool next(int i, Unit& u) const { const int x = c & 7, j = c >> 3, pp = G >> 6; const int pm = (i * 8 + x) * pp + (j >> 3); if ((j >> 3) >= pp || pm >= nM) return false; u.pm = pm; u.pn = j & 7; return true; }
};

__device__ __forceinline__ void xst(unsigned* p, float v) { __hip_atomic_store(p, __builtin_bit_cast(unsigned, v), __ATOMIC_RELAXED, __HIP_MEMORY_SCOPE_AGENT); }
__device__ __forceinline__ float xld(unsigned* p) { return __builtin_bit_cast(float, __hip_atomic_load(p, __ATOMIC_RELAXED, __HIP_MEMORY_SCOPE_AGENT)); }

template <int KIND> struct EpiFused {
    static constexpr bool FUSED = true;
    const float* xres; const bf16_t* x1b_in; bf16_t* x1b_out; float* out; const float* gain;
    unsigned* ssb; unsigned* cnt; unsigned* ssb2; unsigned* cnt2; float* r2; const float* rinv;
    __device__ __forceinline__ void operator()(const f32x4 (&acc)[2][2][4][2], const Unit& u, int wr, int wc, int fr, int fq, LAS unsigned char* xl, int tid) const {
        LAS float* P = (LAS float*)xl; LAS float* R = (LAS float*)(xl + 4096); volatile LAS unsigned* flag = (volatile LAS unsigned*)(xl + 5120); LAS float* RI = (LAS float*)(xl + 5184);
        const int prow = u.pm * BM, col0 = u.pn * BM + wc * 32 + 8 * fq;
        u32x4 pb[(KIND == 6) ? 2 : 1][2][4];
#pragma unroll
        for (int bj = 0; bj < ((KIND == 6) ? 2 : 1); ++bj)
#pragma unroll
            for (int ai = 0; ai < 2; ++ai)
#pragma unroll
                for (int m = 0; m < 4; ++m) { const unsigned off = (unsigned)(prow + ai * HALF + wr * 64 + m * 16 + fr) * (unsigned)DM + (unsigned)(col0 + bj * HALF);
                    pb[bj][ai][m] = *(const u32x4*)(x1b_in + off); }
#pragma unroll
        for (int ai = 0; ai < 2; ++ai)
#pragma unroll
            for (int m = 0; m < 4; ++m) {
                float s = 0.f;
#pragma unroll
                for (int bj = 0; bj < 2; ++bj) { const f32x4 v0 = acc[ai][bj][m][0], v1 = acc[ai][bj][m][1];
                    s += (v0[0] * v0[0] + v0[1] * v0[1]) + (v0[2] * v0[2] + v0[3] * v0[3]) + (v1[0] * v1[0] + v1[1] * v1[1]) + (v1[2] * v1[2] + v1[3] * v1[3]); }
                s += __shfl_xor(s, 16); s += __shfl_xor(s, 32);
                if (fq == 0) P[(ai * HALF + wr * 64 + m * 16 + fr) * 4 + wc] = s;
            }
        asm volatile("s_waitcnt lgkmcnt(0)" ::: "memory"); __builtin_amdgcn_s_barrier(); asm volatile("" ::: "memory");
        if (tid < BM) { const f32x4 q = *(const LAS f32x4*)(P + tid * 4); xst(ssb + (size_t)(prow + tid) * 8 + u.pn, (q.x + q.y) + (q.z + q.w)); }
        asm volatile("s_waitcnt vmcnt(0) lgkmcnt(0)" ::: "memory"); __builtin_amdgcn_s_barrier(); asm volatile("" ::: "memory");
        if (tid == 0) {
            unsigned* cw = cnt + u.pm * 16;
            (void)__hip_atomic_fetch_add(cw, 1u, __ATOMIC_RELAXED, __HIP_MEMORY_SCOPE_AGENT);
            unsigned sp = 0;
            while (__hip_atomic_load(cw, __ATOMIC_RELAXED, __HIP_MEMORY_SCOPE_AGENT) < 8u) { __builtin_amdgcn_s_sleep(1); if (++sp > (1u << 22)) break; }
            __builtin_amdgcn_fence(__ATOMIC_ACQUIRE, "agent");
        }
        asm volatile("s_waitcnt vmcnt(0) lgkmcnt(0)" ::: "memory"); __builtin_amdgcn_s_barrier(); asm volatile("" ::: "memory");
        if (tid < BM) { unsigned* sp8 = ssb + (size_t)(prow + tid) * 8; float s = 0.f;
#pragma unroll
            for (int k = 0; k < 8; ++k) s += xld(sp8 + k);
            R[tid] = rsqrtf(s * (1.0f / DM) + EPS); RI[tid] = (KIND == 5) ? rinv[prow + tid] : 1.0f; }
        asm volatile("s_waitcnt vmcnt(0) lgkmcnt(0)" ::: "memory"); __builtin_amdgcn_s_barrier(); asm volatile("" ::: "memory");
#pragma unroll
        for (int bj = 0; bj < 2; ++bj) {
            const f32x4 g0 = *(const f32x4*)(gain + col0 + bj * HALF), g1 = *(const f32x4*)(gain + col0 + bj * HALF + 4);
            if (KIND == 5 && bj == 1) {
#pragma unroll
                for (int ai = 0; ai < 2; ++ai)
#pragma unroll
                    for (int m = 0; m < 4; ++m) { const unsigned off = (unsigned)(prow + ai * HALF + wr * 64 + m * 16 + fr) * (unsigned)DM + (unsigned)(col0 + HALF);
                        pb[0][ai][m] = *(const u32x4*)(x1b_in + off); }
            }
#pragma unroll
            for (int ai = 0; ai < 2; ++ai) {
                float s2q[4] = {0.f, 0.f, 0.f, 0.f};
#pragma unroll
                for (int m = 0; m < 4; ++m) {
                    const int lrow = ai * HALF + wr * 64 + m * 16 + fr;
                    const unsigned off = (unsigned)(prow + lrow) * (unsigned)DM + (unsigned)(col0 + bj * HALF);
                    const float rr = R[lrow];
                    f32x4 a0, a1;
                    { const u32x4 xb = pb[(KIND == 6) ? bj : 0][ai][m]; a0 = (f32x4){bf_lo(xb.x), bf_hi(xb.x), bf_lo(xb.y), bf_hi(xb.y)}; a1 = (f32x4){bf_lo(xb.z), bf_hi(xb.z), bf_lo(xb.w), bf_hi(xb.w)}; }
                    if (KIND == 5) { const float ri = RI[lrow]; a0 = a0 * ri; a1 = a1 * ri; }
                    const f32x4 v0 = a0 + acc[ai][bj][m][0] * rr * g0, v1 = a1 + acc[ai][bj][m][1] * rr * g1;
                    if (KIND == 5) {
                        u32x4 w; w.x = cvt_pk_bf16(v0[0], v0[1]); w.y = cvt_pk_bf16(v0[2], v0[3]); w.z = cvt_pk_bf16(v1[0], v1[1]); w.w = cvt_pk_bf16(v1[2], v1[3]);
                        *(u32x4*)(x1b_out + off) = w;
                        s2q[m] += (v0[0] * v0[0] + v0[1] * v0[1]) + (v0[2] * v0[2] + v0[3] * v0[3]) + (v1[0] * v1[0] + v1[1] * v1[1]) + (v1[2] * v1[2] + v1[3] * v1[3]);
                    } else { *(f32x4*)(out + off) = v0; *(f32x4*)(out + off + 4) = v1; }
                }
                if (KIND == 5) {
#pragma unroll
                    for (int m = 0; m < 4; ++m) { float t2 = s2q[m]; t2 += __shfl_xor(t2, 16); t2 += __shfl_xor(t2, 32);
                        if (fq == 0) { LAS float* pp = P + (ai * HALF + wr * 64 + m * 16 + fr) * 4 + wc; if (bj == 0) *pp = t2; else *pp += t2; } }
                }
                asm volatile("" ::: "memory");
            }
        }
        if (KIND == 5) {
            asm volatile("s_waitcnt lgkmcnt(0)" ::: "memory"); __builtin_amdgcn_s_barrier(); asm volatile("" ::: "memory");
            if (tid < BM) { const f32x4 q = *(const LAS f32x4*)(P + tid * 4); xst(ssb2 + (size_t)(prow + tid) * 8 + u.pn, (q.x + q.y) + (q.z + q.w)); }
            asm volatile("s_waitcnt vmcnt(0) lgkmcnt(0)" ::: "memory"); __builtin_amdgcn_s_barrier(); asm volatile("" ::: "memory");
            if (tid == 0) flag[0] = __hip_atomic_fetch_add(cnt2 + u.pm * 16, 1u, __ATOMIC_RELAXED, __HIP_MEMORY_SCOPE_AGENT);
            asm volatile("s_waitcnt vmcnt(0) lgkmcnt(0)" ::: "memory"); __builtin_amdgcn_s_barrier(); asm volatile("" ::: "memory");
            if (flag[0] == 7u && tid < BM) { unsigned* sp8 = ssb2 + (size_t)(prow + tid) * 8; float s = 0.f;
#pragma unroll
                for (int k = 0; k < 8; ++k) s += xld(sp8 + k);
                r2[prow + tid] = rsqrtf(s * (1.0f / DM) + EPS); }
            asm volatile("s_waitcnt lgkmcnt(0)" ::: "memory"); __builtin_amdgcn_s_barrier(); asm volatile("" ::: "memory");
        }
    }
};

template <class EpiT, class Sched>
__device__ __forceinline__ void gemm_phase(LAS unsigned char* lds, const Gemm g, const Sched& S, const EpiT& E) {
    int tid_ = threadIdx.x; asm volatile("" : "+v"(tid_));
    const int tid = tid_, wid = __builtin_amdgcn_readfirstlane(tid >> 6), lane = tid & 63, wr = wid >> 2, wc = wid & 3, fr = lane & 15, fq = lane >> 4;
    const int K = g.K, nt = K / BK;
    unsigned voffA[2], voffB[2];
#pragma unroll
    for (int i = 0; i < 2; ++i) { int R, C; stage_rc(tid * 16 + i * 8192, R, C); const int Rb = (R & ~31) + perm32(R & 31);
        voffA[i] = (unsigned)(R * g.lda + C) * 2u; voffB[i] = (unsigned)(Rb * g.ldb + C) * 2u; }
    const size_t kstep = (size_t)(BK * 2);
    const size_t hstepA = (size_t)HALF * g.lda * 2, hstepB = (size_t)HALF * g.ldb * 2;
    const size_t tstepA = 2 * hstepA, tstepB = 2 * hstepB;
    const unsigned ldsw = (unsigned)wid * 1024u;
    const int aoff = lds_byte(wr * 64 + fr, fq * 8), boff = lds_byte(wc * 32 + fr, fq * 8);
#define PG8_SA(b, h) (((b) * 2 + (h)) * HTB)
#define PG8_SB(b, h) ((4 + (b) * 2 + (h)) * HTB)
#define PG8_STAGE(bufoff, gbase, voff) do { _Pragma("unroll") for (int _i = 0; _i < 2; ++_i) \
        __builtin_amdgcn_global_load_lds((const unsigned*)((const char*)(gbase) + (voff)[_i]), (LAS unsigned*)(lds + (bufoff) + ldsw + _i * 8192), 16, 0, 0); } while (0)
#define PG8_LDA(dst, b, h) do { _Pragma("unroll") for (int m = 0; m < 4; ++m) _Pragma("unroll") for (int k = 0; k < 2; ++k) dst[m][k] = *(const LAS bf16x8*)(lds + PG8_SA(b, h) + aoff + m * 2048 + k * 1024); } while (0)
#define PG8_LDB(dst, b, h) do { _Pragma("unroll") for (int n = 0; n < 2; ++n) _Pragma("unroll") for (int k = 0; k < 2; ++k) dst[n][k] = *(const LAS bf16x8*)(lds + PG8_SB(b, h) + boff + n * 2048 + k * 1024); } while (0)
#define PG8_MMA(ai, bj, At, Bt) do { __builtin_amdgcn_s_setprio(1); _Pragma("unroll") for (int m = 0; m < 4; ++m) _Pragma("unroll") for (int n = 0; n < 2; ++n) _Pragma("unroll") for (int k = 0; k < 2; ++k) \
        acc[ai][bj][m][n] = __builtin_amdgcn_mfma_f32_16x16x32_bf16(Bt[n][k], At[m][k], acc[ai][bj][m][n], 0, 0, 0); __builtin_amdgcn_s_setprio(0); } while (0)
#define PG8_WAIT_V(n) asm volatile("s_waitcnt vmcnt(" #n ")" ::: "memory")
#define PG8_WAIT_L(n) asm volatile("s_waitcnt lgkmcnt(" #n ")" ::: "memory")
#define PG8_BAR __builtin_amdgcn_s_barrier()
#define PG8_SCHED __builtin_amdgcn_sched_barrier(0)
    Unit cur, nxt; int ui = 0;
    if (!S.next(0, cur)) return;
    f32x4 acc[2][2][4][2];
#pragma unroll
    for (int a = 0; a < 2; ++a)
#pragma unroll
        for (int b = 0; b < 2; ++b)
#pragma unroll
            for (int m = 0; m < 4; ++m)
#pragma unroll
                for (int n = 0; n < 2; ++n) acc[a][b][m][n] = (f32x4){0.f, 0.f, 0.f, 0.f};
    bf16x8 At[4][2], B0[2][2], B1[2][2];
    const char* cA = (const char*)g.A + (size_t)cur.pm * tstepA + (size_t)cur.pn * g.a_pn_bytes; const char* cB = (const char*)g.Bt + (size_t)cur.pn * tstepB;
    PG8_STAGE(PG8_SB(0, 0), cB, voffB); PG8_STAGE(PG8_SB(0, 1), cB + hstepB, voffB); PG8_STAGE(PG8_SA(0, 0), cA, voffA); PG8_STAGE(PG8_SA(0, 1), cA + hstepA, voffA);
    if (wr == 1) PG8_BAR;
    PG8_WAIT_V(2); PG8_BAR;
    PG8_STAGE(PG8_SB(1, 0), cB + kstep, voffB); PG8_STAGE(PG8_SA(1, 0), cA + kstep, voffA); PG8_STAGE(PG8_SB(1, 1), cB + hstepB + kstep, voffB);
    PG8_WAIT_V(6); PG8_BAR;
    for (;;) {
        const bool has_next = S.next(ui + 1, nxt);
        const char* nA = has_next ? (const char*)g.A + (size_t)nxt.pm * tstepA + (size_t)nxt.pn * g.a_pn_bytes : cA; const char* nB = has_next ? (const char*)g.Bt + (size_t)nxt.pn * tstepB : cB;
#pragma nounroll
        for (int t = 0; t < nt; t += 2) {
            const bool last = (t == nt - 2);
            const char* a1 = cA + (size_t)(t + 1) * kstep;
            const char* a2 = last ? nA : cA + (size_t)(t + 2) * kstep; const char* b2 = last ? nB : cB + (size_t)(t + 2) * kstep;
            const char* a3 = a2 + kstep; const char* b3 = b2 + kstep;
            PG8_LDB(B0, 0, 0); PG8_LDB(B1, 0, 1); PG8_SCHED; PG8_LDA(At, 0, 0); PG8_STAGE(PG8_SA(1, 1), a1 + hstepA, voffA);
            PG8_WAIT_V(8); PG8_WAIT_L(0); PG8_BAR; PG8_MMA(0, 0, At, B0); PG8_MMA(0, 1, At, B1); PG8_BAR; PG8_SCHED;
            PG8_LDA(At, 0, 1); PG8_STAGE(PG8_SB(0, 0), b2, voffB); PG8_STAGE(PG8_SB(0, 1), b2 + hstepB, voffB); PG8_STAGE(PG8_SA(0, 0), a2, voffA);
            PG8_WAIT_V(8); PG8_WAIT_L(0); PG8_BAR; PG8_MMA(1, 0, At, B0); PG8_MMA(1, 1, At, B1); PG8_BAR; PG8_SCHED;
            PG8_LDB(B0, 1, 0); PG8_LDB(B1, 1, 1); PG8_SCHED; PG8_LDA(At, 1, 0); PG8_STAGE(PG8_SA(0, 1), a2 + hstepA, voffA);
            PG8_WAIT_V(8); PG8_WAIT_L(0); PG8_BAR; PG8_MMA(0, 0, At, B0); PG8_MMA(0, 1, At, B1); PG8_BAR; PG8_SCHED;
            PG8_LDA(At, 1, 1); PG8_STAGE(PG8_SB(1, 0), b3, voffB); PG8_STAGE(PG8_SB(1, 1), b3 + hstepB, voffB); PG8_STAGE(PG8_SA(1, 0), a3, voffA);
            PG8_WAIT_V(8); PG8_WAIT_L(0); PG8_BAR; PG8_MMA(1, 0, At, B0); PG8_MMA(1, 1, At, B1); PG8_BAR; PG8_SCHED;
        }
        if (wr == 0) PG8_BAR;
        if constexpr (EpiT::FUSED) E(acc, cur, wr, wc, fr, fq, lds + XCH_OFF, tid); else E(acc, cur, wr, wc, fr, fq);
        if (!has_next) break;
#pragma unroll
        for (int a = 0; a < 2; ++a)
#pragma unroll
            for (int b = 0; b < 2; ++b)
#pragma unroll
                for (int m = 0; m < 4; ++m)
#pragma unroll
                    for (int n = 0; n < 2; ++n) acc[a][b][m][n] = (f32x4){0.f, 0.f, 0.f, 0.f};
        cur = nxt; cA = nA; cB = nB; ++ui;
        if (wr == 1) PG8_BAR;
    }
    PG8_WAIT_V(0);
    PG8_BAR;
#undef PG8_SA
#undef PG8_SB
#undef PG8_STAGE
#undef PG8_LDA
#undef PG8_LDB
#undef PG8_MMA
#undef PG8_WAIT_V
#undef PG8_WAIT_L
#undef PG8_BAR
#undef PG8_SCHED
}
}

__device__ __forceinline__ void p0_transpose_item(const float* W, int K, int N, bf16_t* WT, LAS float* scr, int item, int lane, const float* colscale = nullptr, const float* rowscale = nullptr) {
    const int nblk = N / 32, kb = item / nblk, nb = item % nblk, k0 = 64 * kb, n0 = 32 * nb;
    const int lr = lane >> 3, lc = (lane & 7) * 4;
    f32x4 v[8];
#pragma unroll
    for (int i = 0; i < 8; ++i) v[i] = __builtin_nontemporal_load((const f32x4*)(W + (size_t)(k0 + lr + 8 * i) * N + n0 + lc));
    f32x4 cs = (f32x4){1.f, 1.f, 1.f, 1.f};
    if (colscale) cs = *(const f32x4*)(colscale + n0 + lc);
#pragma unroll
    for (int i = 0; i < 8; ++i) { const int kk = lr + 8 * i; const float rs = rowscale ? rowscale[k0 + kk] : 1.0f; const f32x4 t = v[i] * cs * rs;
        LAS float* d = scr + kk * 33 + lc; d[0] = t.x; d[1] = t.y; d[2] = t.z; d[3] = t.w; }
    LDS_WAIT(); asm volatile("" ::: "memory");
    const int c = lane & 7;
#pragma unroll
    for (int j = 0; j < 4; ++j) { const int n = (lane >> 3) + 8 * j; const LAS float* s = scr + (8 * c) * 33 + n;
        u32x4 o; o.x = cvt_pk_bf16(s[0 * 33], s[1 * 33]); o.y = cvt_pk_bf16(s[2 * 33], s[3 * 33]); o.z = cvt_pk_bf16(s[4 * 33], s[5 * 33]); o.w = cvt_pk_bf16(s[6 * 33], s[7 * 33]);
        *(u32x4*)(WT + (size_t)(n0 + n) * K + k0 + 8 * c) = o; }
    LDS_WAIT(); asm volatile("" ::: "memory");
}

template <int R>
__device__ __forceinline__ void rms_rows_to_bf16(const float* x, float* rinv, bf16_t* o, int m0, int mstride, int lane) {
    f32x4 v[R][8];
#pragma unroll
    for (int r = 0; r < R; ++r) { const f32x4* xr = (const f32x4*)(x + (size_t)(m0 + r * mstride) * DM) + lane;
#pragma unroll
        for (int j = 0; j < 8; ++j) v[r][j] = xr[64 * j]; }
#pragma unroll
    for (int r = 0; r < R; ++r) {
        float s = 0.f;
#pragma unroll
        for (int j = 0; j < 8; ++j) s += (v[r][j].x * v[r][j].x + v[r][j].y * v[r][j].y) + (v[r][j].z * v[r][j].z + v[r][j].w * v[r][j].w);
        const float ms = wave_sum(s) * (1.f / DM) + EPS; const float rr = rsqrtf(ms);
        if (lane == 0) rinv[m0 + r * mstride] = sqrtf(ms);
        u32x2* o8 = (u32x2*)(o + (size_t)(m0 + r * mstride) * DM) + lane;
#pragma unroll
        for (int j = 0; j < 8; ++j) { u32x2 ob; ob.x = cvt_pk_bf16(v[r][j].x * rr, v[r][j].y * rr); ob.y = cvt_pk_bf16(v[r][j].z * rr, v[r][j].w * rr); o8[64 * j] = ob; }
    }
}

constexpr int H_QD = 0, H_KT = 16384, H_KDT = 32768, H_VT = 49152, H_ST = 65536, H_PP = 98304, H_SEG = 106496, H_EL = 110592;
#define A256(base, row, ch) ((base) + (row) * 256 + ((((ch)) ^ ((row) & 15)) << 4))
#define A128(base, row, ch) ((base) + (row) * 128 + ((((ch)) ^ (((row) >> 1) & 7)) << 4))
constexpr int PITCH_T = 272;
constexpr int PITCH_S = 144;
#define MFMA16(a, b, c) __builtin_amdgcn_mfma_f32_16x16x32_bf16((a), (b), (c), 0, 0, 0)
#define HSYNC() do { asm volatile("s_waitcnt lgkmcnt(0)" ::: "memory"); __builtin_amdgcn_s_barrier(); asm volatile("" ::: "memory"); } while (0)

__device__ __forceinline__ void hgrn_unit(LAS unsigned char* lds, const bf16_t* proj, bf16_t* Y, const float* hnw, int bh) {
    const int tid = opaque_tid(), w = __builtin_amdgcn_readfirstlane(tid >> 6), lane = tid & 63, fr = lane & 15, fq = lane >> 4;
    const int b = bh >> 3, h = bh & 7;
    const unsigned* P32 = (const unsigned*)proj;
    const size_t rowbase = (size_t)b * SEQ + 8 * w;
    const int cq = (PW + h * HD) / 2 + lane, cf = (PW + HW + h * HD) / 2 + lane, cv = (PW + 2 * HW + h * HD) / 2 + lane;
    const int orow = lane >> 3, oseg = lane & 7;
    const u32x4* P128 = (const u32x4*)proj;
    const int cg16 = (PW + 3 * HW + h * HD) / 8 + 2 * oseg;
    u32x4* Y128 = (u32x4*)Y;
    const int cy16 = (PW + h * HD) / 8 + 2 * oseg;
    float nw[16];
#pragma unroll
    for (int j = 0; j < 16; ++j) nw[j] = hnw[h * HD + 16 * oseg + j];

    f32x4 S[2][4];
#pragma unroll
    for (int di = 0; di < 2; ++di)
#pragma unroll
        for (int ej = 0; ej < 4; ++ej) S[di][ej] = (f32x4){0.f, 0.f, 0.f, 0.f};
    const int dt0 = 2 * (w >> 1), et0 = 4 * (w & 1);
#pragma unroll
    for (int di = 0; di < 2; ++di)
#pragma unroll
        for (int ej = 0; ej < 4; ++ej) *(LAS u32x2*)(lds + A256(H_ST, 16 * (et0 + ej) + fr, 2 * (dt0 + di) + (fq >> 1)) + (fq & 1) * 8) = (u32x2){0u, 0u};

    const __amdgpu_buffer_rsrc_t rsrc = __builtin_amdgcn_make_buffer_rsrc((void*)proj, 0, M * INW * 2, 0x00020000);
    const unsigned vq = (unsigned)lane * 4u, vg = (unsigned)(orow * (INW * 2) + oseg * 32);
    unsigned rq[8], rf[8], rv[8]; u32x4 rg0, rg1, ng0, ng1;
#pragma unroll
    for (int i = 0; i < 8; ++i) { const size_t r = (rowbase + i) * (INW / 2); rq[i] = P32[r + cq]; rf[i] = P32[r + cf]; rv[i] = P32[r + cv]; }
    { const size_t r = (rowbase + orow) * (INW / 8); rg0 = P128[r + cg16]; rg1 = P128[r + cg16 + 1]; }

    for (int c = 0; c < NCHUNK; ++c) {
        float kk[8][2], bl[8][2]; float cum0 = 1.f, cum1 = 1.f;
#pragma unroll
        for (int i = 0; i < 8; ++i) {
            kk[i][0] = bf_lo(rf[i]); kk[i][1] = bf_hi(rf[i]);
            cum0 *= 1.0f - kk[i][0]; cum1 *= 1.0f - kk[i][1];
            bl[i][0] = cum0; bl[i][1] = cum1;
        }
        *(LAS f32x2*)(lds + H_SEG + (w * 128 + 2 * lane) * 4) = (f32x2){cum0, cum1};
        HSYNC();
        float pre0 = 1.f, pre1 = 1.f, tot0 = 1.f, tot1 = 1.f;
#pragma unroll
        for (int ww = 0; ww < 8; ++ww) { const f32x2 sgv = *(const LAS f32x2*)(lds + H_SEG + (ww * 128 + 2 * lane) * 4); tot0 *= sgv.x; tot1 *= sgv.y; if (ww < w) { pre0 *= sgv.x; pre1 *= sgv.y; } }
        unsigned kd0[4], kd1[4], vt0[4], vt1[4];
#pragma unroll
        for (int i = 0; i < 8; ++i) {
            const float p0 = fmaxf(pre0 * bl[i][0], 1e-30f), p1 = fmaxf(pre1 * bl[i][1], 1e-30f);
            const float q0 = bf_lo(rq[i]) * p0, q1 = bf_hi(rq[i]) * p1;
            const float k0 = kk[i][0] * __builtin_amdgcn_rcpf(p0), k1 = kk[i][1] * __builtin_amdgcn_rcpf(p1);
            const float e0 = k0 * tot0, e1 = k1 * tot1;
            const int t = 8 * w + i;
            *(LAS unsigned*)(lds + A256(H_QD, t, lane >> 2) + (lane & 3) * 4) = cvt_pk_bf16(q0, q1);
            *(LAS unsigned*)(lds + A256(H_KT, t, lane >> 2) + (lane & 3) * 4) = cvt_pk_bf16(k0, k1);
            const unsigned ep = cvt_pk_bf16(e0, e1);
            if (i & 1) { kd0[i >> 1] |= ep << 16; kd1[i >> 1] |= ep & 0xffff0000u; vt0[i >> 1] |= rv[i] << 16; vt1[i >> 1] |= rv[i] & 0xffff0000u; }
            else { kd0[i >> 1] = ep & 0xffffu; kd1[i >> 1] = ep >> 16; vt0[i >> 1] = rv[i] & 0xffffu; vt1[i >> 1] = rv[i] >> 16; }
        }
        *(LAS u32x4*)(lds + A128(H_KDT, 2 * lane, w)) = (u32x4){kd0[0], kd0[1], kd0[2], kd0[3]};
        *(LAS u32x4*)(lds + A128(H_KDT, 2 * lane + 1, w)) = (u32x4){kd1[0], kd1[1], kd1[2], kd1[3]};
        *(LAS u32x4*)(lds + A128(H_VT, 2 * lane, w)) = (u32x4){vt0[0], vt0[1], vt0[2], vt0[3]};
        *(LAS u32x4*)(lds + A128(H_VT, 2 * lane + 1, w)) = (u32x4){vt1[0], vt1[1], vt1[2], vt1[3]};
        if (w == 0) *(LAS f32x2*)(lds + H_EL + lane * 8) = (f32x2){tot0, tot1};
        if (c + 1 < NCHUNK) {
            const unsigned rrow = (unsigned)(b * SEQ + 8 * w + (c + 1) * CHUNK);
            const unsigned sq = (rrow * (unsigned)INW + (unsigned)(PW + h * HD)) * 2u;
#pragma unroll
            for (int i = 0; i < 8; ++i) {
                rq[i] = __builtin_amdgcn_raw_buffer_load_b32(rsrc, vq, sq + (unsigned)(i * INW * 2), 0);
                rf[i] = __builtin_amdgcn_raw_buffer_load_b32(rsrc, vq, sq + (unsigned)(i * INW * 2 + HW * 2), 0);
                rv[i] = __builtin_amdgcn_raw_buffer_load_b32(rsrc, vq, sq + (unsigned)(i * INW * 2 + 2 * HW * 2), 0);
            }
            ng0 = __builtin_bit_cast(u32x4, __builtin_amdgcn_raw_buffer_load_b128(rsrc, vg, sq + (unsigned)(3 * HW * 2), 0));
            ng1 = __builtin_bit_cast(u32x4, __builtin_amdgcn_raw_buffer_load_b128(rsrc, vg, sq + (unsigned)(3 * HW * 2 + 16), 0));
        }
        HSYNC();
        {
            const int si = w >> 1;
#pragma unroll
            for (int tt = 0; tt < 2; ++tt) {
                const int ti = 2 * (w & 1) + tt;
                f32x4 a = (f32x4){0.f, 0.f, 0.f, 0.f};
                if (si <= ti) {
#pragma unroll
                    for (int ks = 0; ks < 4; ++ks) {
                        const bf16x8 A = *(const LAS bf16x8*)(lds + A256(H_KT, 16 * si + fr, fq + 4 * ks));
                        const bf16x8 B = *(const LAS bf16x8*)(lds + A256(H_QD, 16 * ti + fr, fq + 4 * ks));
                        a = MFMA16(A, B, a);
                    }
                    if (si == ti) {
#pragma unroll
                        for (int r = 0; r < 4; ++r) if (4 * fq + r > fr) a[r] = 0.f;
                    }
                }
                *(LAS u32x2*)(lds + A128(H_PP, 16 * ti + fr, 2 * si + (fq >> 1)) + (fq & 1) * 8) = (u32x2){cvt_pk_bf16(a[0], a[1]), cvt_pk_bf16(a[2], a[3])};
            }
        }
        HSYNC();
        {
            f32x4 o[4];
#pragma unroll
            for (int ti = 0; ti < 4; ++ti) o[ti] = (f32x4){0.f, 0.f, 0.f, 0.f};
#pragma unroll
            for (int ks = 0; ks < 4; ++ks) {
                const bf16x8 A = *(const LAS bf16x8*)(lds + A256(H_ST, 16 * w + fr, fq + 4 * ks));
#pragma unroll
                for (int ti = 0; ti < 4; ++ti) { const bf16x8 B = *(const LAS bf16x8*)(lds + A256(H_QD, 16 * ti + fr, fq + 4 * ks)); o[ti] = MFMA16(A, B, o[ti]); }
            }
#pragma unroll
            for (int ks = 0; ks < 2; ++ks) {
                const bf16x8 A = *(const LAS bf16x8*)(lds + A128(H_VT, 16 * w + fr, fq + 4 * ks));
#pragma unroll
                for (int ti = 0; ti < 4; ++ti) { const bf16x8 B = *(const LAS bf16x8*)(lds + A128(H_PP, 16 * ti + fr, fq + 4 * ks)); o[ti] = MFMA16(A, B, o[ti]); }
            }
#pragma unroll
            for (int ti = 0; ti < 4; ++ti) *(LAS u32x2*)(lds + A256(H_KT, 16 * ti + fr, 2 * w + (fq >> 1)) + (fq & 1) * 8) = (u32x2){cvt_pk_bf16(o[ti][0], o[ti][1]), cvt_pk_bf16(o[ti][2], o[ti][3])};
        }
        {
#pragma unroll
            for (int di = 0; di < 2; ++di) {
                const f32x4 el = *(const LAS f32x4*)(lds + H_EL + (16 * (dt0 + di) + 4 * fq) * 4);
#pragma unroll
                for (int ej = 0; ej < 4; ++ej) S[di][ej] = S[di][ej] * el;
            }
#pragma unroll
            for (int ks = 0; ks < 2; ++ks) {
                bf16x8 A[2], B[4];
#pragma unroll
                for (int di = 0; di < 2; ++di) A[di] = *(const LAS bf16x8*)(lds + A128(H_KDT, 16 * (dt0 + di) + fr, fq + 4 * ks));
#pragma unroll
                for (int ej = 0; ej < 4; ++ej) B[ej] = *(const LAS bf16x8*)(lds + A128(H_VT, 16 * (et0 + ej) + fr, fq + 4 * ks));
#pragma unroll
                for (int di = 0; di < 2; ++di)
#pragma unroll
                    for (int ej = 0; ej < 4; ++ej) S[di][ej] = MFMA16(A[di], B[ej], S[di][ej]);
            }
        }
        HSYNC();
#pragma unroll
        for (int di = 0; di < 2; ++di)
#pragma unroll
            for (int ej = 0; ej < 4; ++ej)
                *(LAS u32x2*)(lds + A256(H_ST, 16 * (et0 + ej) + fr, 2 * (dt0 + di) + (fq >> 1)) + (fq & 1) * 8) = (u32x2){cvt_pk_bf16(S[di][ej][0], S[di][ej][1]), cvt_pk_bf16(S[di][ej][2], S[di][ej][3])};
        {
            const u32x4 oa = *(const LAS u32x4*)(lds + A256(H_KT, 8 * w + orow, 2 * oseg));
            const u32x4 ob = *(const LAS u32x4*)(lds + A256(H_KT, 8 * w + orow, 2 * oseg + 1));
            const unsigned ou[8] = {oa.x, oa.y, oa.z, oa.w, ob.x, ob.y, ob.z, ob.w};
            const unsigned gu[8] = {rg0.x, rg0.y, rg0.z, rg0.w, rg1.x, rg1.y, rg1.z, rg1.w};
            float gv[16]; float ssq = 0.f;
#pragma unroll
            for (int j = 0; j < 8; ++j) { gv[2 * j] = bf_lo(ou[j]) * bf_lo(gu[j]); gv[2 * j + 1] = bf_hi(ou[j]) * bf_hi(gu[j]); ssq += gv[2 * j] * gv[2 * j] + gv[2 * j + 1] * gv[2 * j + 1]; }
            ssq += __shfl_xor(ssq, 1); ssq += __shfl_xor(ssq, 2); ssq += __shfl_xor(ssq, 4);
            const float r = rsqrtf(ssq * (1.0f / HD) + EPS);
            u32x4 y0, y1;
            y0.x = cvt_pk_bf16(gv[0] * r * nw[0], gv[1] * r * nw[1]); y0.y = cvt_pk_bf16(gv[2] * r * nw[2], gv[3] * r * nw[3]);
            y0.z = cvt_pk_bf16(gv[4] * r * nw[4], gv[5] * r * nw[5]); y0.w = cvt_pk_bf16(gv[6] * r * nw[6], gv[7] * r * nw[7]);
            y1.x = cvt_pk_bf16(gv[8] * r * nw[8], gv[9] * r * nw[9]); y1.y = cvt_pk_bf16(gv[10] * r * nw[10], gv[11] * r * nw[11]);
            y1.z = cvt_pk_bf16(gv[12] * r * nw[12], gv[13] * r * nw[13]); y1.w = cvt_pk_bf16(gv[14] * r * nw[14], gv[15] * r * nw[15]);
            const size_t yr = (rowbase + (size_t)c * CHUNK + orow) * (DM / 8);
            Y128[yr + cy16] = y0; Y128[yr + cy16 + 1] = y1;
        }
        rg0 = ng0; rg1 = ng1;
    }
    __syncthreads();
}

__device__ __forceinline__ void pool_diff_unit(const bf16_t* proj, bf16_t* D, int unit) {
    const int tid = opaque_tid(), tq = tid >> 7, cgp = tid & 127;
    const int b = unit >> 5, tc = unit & 31;
    const int j = cgp >> 5, win = 2 << j;
    const int t0 = tc * 64 + tq * 16;
    const u32x4* P = (const u32x4*)proj + (size_t)b * SEQ * (INW / 8) + cgp;
    u32x4 row[32];
#pragma unroll
    for (int r = 0; r < 32; ++r) { const int t = t0 - 16 + r; row[r] = (t >= 0) ? P[(size_t)t * (INW / 8)] : (u32x4){0u, 0u, 0u, 0u}; }
    float sum[8];
#pragma unroll
    for (int e = 0; e < 8; ++e) sum[e] = 0.f;
#pragma unroll
    for (int k = 1; k <= 16; ++k) {
        const float mk = (k <= win) ? 1.f : 0.f; const u32x4 v = row[16 - k];
        sum[0] += mk * bf_lo(v.x); sum[1] += mk * bf_hi(v.x); sum[2] += mk * bf_lo(v.y); sum[3] += mk * bf_hi(v.y);
        sum[4] += mk * bf_lo(v.z); sum[5] += mk * bf_hi(v.z); sum[6] += mk * bf_lo(v.w); sum[7] += mk * bf_hi(v.w);
    }
    const float invw = (j == 0) ? 0.5f : (j == 1) ? 0.25f : (j == 2) ? 0.125f : 0.0625f;
    u32x4* Dp = (u32x4*)D + ((size_t)b * SEQ + t0) * (PW / 8) + cgp;
#pragma unroll
    for (int i = 0; i < 16; ++i) {
        const u32x4 v = row[16 + i];
        const u32x4 a = row[16 + i - 2], bq = row[16 + i - 4], cq = row[16 + i - 8], dq = row[i];
        u32x4 o;
        o.x = (j == 0) ? a.x : (j == 1) ? bq.x : (j == 2) ? cq.x : dq.x; o.y = (j == 0) ? a.y : (j == 1) ? bq.y : (j == 2) ? cq.y : dq.y;
        o.z = (j == 0) ? a.z : (j == 1) ? bq.z : (j == 2) ? cq.z : dq.z; o.w = (j == 0) ? a.w : (j == 1) ? bq.w : (j == 2) ? cq.w : dq.w;
        const float u[8] = {bf_lo(v.x), bf_hi(v.x), bf_lo(v.y), bf_hi(v.y), bf_lo(v.z), bf_hi(v.z), bf_lo(v.w), bf_hi(v.w)};
        const float ov[8] = {bf_lo(o.x), bf_hi(o.x), bf_lo(o.y), bf_hi(o.y), bf_lo(o.z), bf_hi(o.z), bf_lo(o.w), bf_hi(o.w)};
#pragma unroll
        for (int e = 0; e < 8; ++e) sum[e] += u[e] - ov[e];
        const int t = t0 + i;
        const float inv = (t + 1 >= win) ? invw : __builtin_amdgcn_rcpf((float)(t + 1));
        u32x4 d; d.x = cvt_pk_bf16(sum[0] * inv - u[0], sum[1] * inv - u[1]); d.y = cvt_pk_bf16(sum[2] * inv - u[2], sum[3] * inv - u[3]);
        d.z = cvt_pk_bf16(sum[4] * inv - u[4], sum[5] * inv - u[5]); d.w = cvt_pk_bf16(sum[6] * inv - u[6], sum[7] * inv - u[7]);
        Dp[(size_t)i * (PW / 8)] = d;
    }
}

#define XB_TMO      128
#define XB_XCNT(j)  (256  + 64 * (j))
#define XB_XSUB(j)  (1280 + 64 * (j))
#define XB_XGEN(j)  (2304 + 64 * (j))
#define XB_TOP      3328
#define XB_TOPGEN   3392
#define XCD_BAR_WORDS 3456
#define XB_SPIN_CAP (1u << 18)

__device__ __forceinline__ unsigned xb_ld(unsigned* p)              { return __hip_atomic_load(p, __ATOMIC_RELAXED, __HIP_MEMORY_SCOPE_AGENT); }
__device__ __forceinline__ unsigned xb_add(unsigned* p, unsigned v) { return __hip_atomic_fetch_add(p, v, __ATOMIC_RELAXED, __HIP_MEMORY_SCOPE_AGENT); }
__device__ __forceinline__ unsigned xb_xcc_id() { return (unsigned)__builtin_amdgcn_s_getreg((3 << 11) | 20) & 0xFu; }
#define XB_SPIN(cond, bar) do { unsigned _sp = 0; while (cond) { __builtin_amdgcn_s_sleep(1); \
    if ((++_sp & 255u) == 0u) { if (xb_ld(&(bar)[XB_TMO])) break; if (_sp > XB_SPIN_CAP) { atomicAdd(&(bar)[XB_TMO], 1u); break; } } } } while (0)

struct XcdBarrier {
    unsigned* bar; unsigned x;
    volatile LAS unsigned* st;
};

__device__ __forceinline__ XcdBarrier xcd_barrier_post(unsigned* bar, volatile LAS unsigned* st) {
    XcdBarrier b; b.bar = bar; b.x = xb_xcc_id(); b.st = st;
    if (threadIdx.x == 0) (void)xb_add(&bar[XB_XCNT(b.x)], 1u);
    return b;
}
__device__ __forceinline__ void xcd_barrier_complete(unsigned* bar, unsigned x, unsigned& nloc, unsigned& nx) {
    const unsigned G = gridDim.x * gridDim.y * gridDim.z;
    unsigned sum, cnt, mine, sp = 0u;
    for (;;) {
        sum = 0u; cnt = 0u; mine = 0u;
#pragma unroll
        for (unsigned j = 0; j < 16; ++j) { const unsigned c = xb_ld(&bar[XB_XCNT(j)]); sum += c; cnt += (c > 0u) ? 1u : 0u; mine = (j == x) ? c : mine; }
        if (sum == G) break;
        __builtin_amdgcn_s_sleep(1);
        if ((++sp & 255u) == 0u) { if (xb_ld(&bar[XB_TMO])) break; if (sp > XB_SPIN_CAP) { atomicAdd(&bar[XB_TMO], 1u); break; } }
    }
    nloc = mine > 0u ? mine : 1u; nx = cnt > 0u ? cnt : 1u;
}

__device__ __forceinline__ void xcd_barrier(const XcdBarrier& b) {
    asm volatile("s_waitcnt vmcnt(0)" ::: "memory");
    __syncthreads();
    if (threadIdx.x == 0) {
        unsigned* bar = b.bar;
        __builtin_amdgcn_s_waitcnt(0);
        unsigned nloc = b.st[0], nx = b.st[1];
        if (nloc == 0u) { xcd_barrier_complete(bar, b.x, nloc, nx); b.st[0] = nloc; b.st[1] = nx; }
        const unsigned old = xb_add(&bar[XB_XSUB(b.x)], 1u);
        const unsigned gen = old / nloc;
        if (old + 1u == (gen + 1u) * nloc) {
            __builtin_amdgcn_fence(__ATOMIC_RELEASE, "agent");
            asm volatile("s_waitcnt vmcnt(0)" ::: "memory");
            const unsigned og = xb_add(&bar[XB_TOP], 1u);
            const unsigned tg = og / nx;
            if (og + 1u == (tg + 1u) * nx) xb_add(&bar[XB_TOPGEN], 1u);
            else XB_SPIN(xb_ld(&bar[XB_TOPGEN]) == tg, bar);
            __builtin_amdgcn_fence(__ATOMIC_ACQUIRE, "agent");
            xb_add(&bar[XB_XGEN(b.x)], 1u);
            asm volatile("s_waitcnt vmcnt(0)" ::: "memory");
        } else {
            XB_SPIN(xb_ld(&bar[XB_XGEN(b.x)]) == gen, bar);
            __builtin_amdgcn_fence(__ATOMIC_ACQUIRE, "agent");
            asm volatile("s_waitcnt vmcnt(0)" ::: "memory");
        }
    }
    __syncthreads();
}

__device__ __forceinline__ void grid_barrier(cg::grid_group& grid) {
    asm volatile("s_waitcnt vmcnt(0)" ::: "memory");
    grid.sync();
    __builtin_amdgcn_fence(__ATOMIC_ACQUIRE, "agent");
    asm volatile("s_waitcnt vmcnt(0)" ::: "memory");
}


#ifdef DBG_STOP
#define DBG_DUMP(k, SRC, LD, COFF) if (DBG_STOP == (k)) { for (int m = gw; m < M; m += NGW) { const unsigned* sr = (const unsigned*)((SRC) + (size_t)m * (LD) + (COFF)); float* orow = p.out + (size_t)m * DM; \
        for (int j = lane; j < DM / 2; j += 64) { const unsigned v = sr[j]; orow[2 * j] = bf_lo(v); orow[2 * j + 1] = bf_hi(v); } } return; }
#else
#define DBG_DUMP(k, SRC, LD, COFF)
#endif

struct Params {
    const float* x; const float* w_in; const float* pool_w; const float* pool_b; const float* pool_scale;
    const float* lb_logits; const float* hgrn_norm_w; const float* w_out;
    const float* n_mix_pre; const float* n_mix_post; const float* n_mlp_pre; const float* n_mlp_post;
    const float* w_mlp_in; const float* w_mlp_out;
    float* out; unsigned char* ws;
};

__global__ void __launch_bounds__(NTHREADS, 2) fwd_megakernel(Params p) {
    extern __shared__ __attribute__((aligned(16))) unsigned char lds_raw[];
    LAS unsigned char* lds = (LAS unsigned char*)lds_raw;
    cg::grid_group grid = cg::this_grid();
    const int G = gridDim.x, bx = blockIdx.x;
    volatile LAS unsigned* xb_st = (volatile LAS unsigned*)(lds + 131072 + 256);
    if (threadIdx.x < 2) xb_st[threadIdx.x] = 0u;
    __syncthreads();
    const XcdBarrier xbar = xcd_barrier_post((unsigned*)(p.ws + WS_BAR), xb_st);
#define SEAM() xcd_barrier(xbar)
    if (G == 0x7fffffff) grid_barrier(grid);
    const int NGW = G * NWAVES;
    unsigned char* ws = p.ws;
    bf16_t* Win_t = (bf16_t*)(ws + WS_WIN); bf16_t* Wout_t = (bf16_t*)(ws + WS_WOUT); bf16_t* W1_t = (bf16_t*)(ws + WS_W1); bf16_t* W2_t = (bf16_t*)(ws + WS_W2);
    bf16_t* Wpool_t = (bf16_t*)(ws + WS_WPOOL);
    float* SS1 = (float*)(ws + WS_SS1); float* SS2 = (float*)(ws + WS_SS2);
    bf16_t* HN = (bf16_t*)(ws + WS_HN); bf16_t* MIX = (bf16_t*)(ws + WS_MIX); bf16_t* DD = (bf16_t*)(ws + WS_D);
    bf16_t* PROJ = (bf16_t*)(ws + WS_PROJ); bf16_t* FFH = (bf16_t*)(ws + WS_FFH);
    float* R2 = (float*)(ws + WS_R2); float* RINV = (float*)(ws + WS_RINV); bf16_t* YB = (bf16_t*)(ws + WS_Y);
    bf16_t* X1B = MIX;
    unsigned* SSB1 = (unsigned*)(ws + WS_SS1); unsigned* SSB1B = (unsigned*)(ws + WS_SS1 + 2 * MiB); unsigned* SSB2 = (unsigned*)(ws + WS_SS2);
    unsigned* CNT_A = (unsigned*)(ws + 131072); unsigned* CNT_B = CNT_A + 128 * 16; unsigned* CNT_C = CNT_B + 128 * 16;
    unsigned* qctr = (unsigned*)ws;

#ifndef PHMASK
#define PHMASK 0x1ff
#endif
#if (PHMASK>>0)&1
    {
        const int tid = opaque_tid(), lane = tid & 63, wave = __builtin_amdgcn_readfirstlane(tid >> 6), gw = bx * NWAVES + wave;
        if (bx == 0 && tid == 0) __hip_atomic_store(qctr, 0u, __ATOMIC_RELAXED, __HIP_MEMORY_SCOPE_AGENT);
        LAS float* scr = (LAS float*)(lds + wave * 16384);
        constexpr int I_IN = (DM / 64) * (INW / 32), I_P = (256 / 64) * (256 / 32);
        constexpr int NITEMS = I_IN + 4 * I_P;
        for (int it = gw; it < NITEMS; it += NGW) {
            int r = it;
            if (r < I_IN) { p0_transpose_item(p.w_in, DM, INW, Win_t, scr, r, lane, nullptr, p.n_mix_pre); continue; } r -= I_IN;
            const int j = r / I_P; r -= j * I_P;
            p0_transpose_item(p.pool_w + (size_t)j * 256 * 256, 256, 256, Wpool_t + (size_t)j * 256 * 256, scr, r, lane, p.pool_scale + j * 256);
        }
        {
            int m = gw;
            for (; m + 3 * NGW < M; m += 4 * NGW) rms_rows_to_bf16<4>(p.x, RINV, HN, m, NGW, lane);
            for (; m < M; m += NGW) rms_rows_to_bf16<1>(p.x, RINV, HN, m, NGW, lane);
        }
    }
    SEAM();

#endif
#if (PHMASK>>1)&1
    {
        pg8::Gemm g{HN, Win_t, DM, DM, DM, 0}; pg8::StaticOrder S; S.init(M, INW, G, bx);
        pg8::Epi<4> E{PROJ, INW, p.lb_logits, nullptr, nullptr};
        pg8::gemm_phase(lds, g, S, E);
    }
    SEAM();
    DBG_DUMP(1, PROJ, INW, 1024)
#endif
#if (PHMASK>>2)&1
    {
        const int NH = (G / 2 < NB * NHEAD) ? G / 2 : NB * NHEAD;
        if (bx < NH) {
            for (int u = bx; u < NB * NHEAD; u += NH) hgrn_unit(lds, PROJ, YB, p.hgrn_norm_w, u);
        } else {
            const int NP = G - NH, pb = bx - NH;
            for (int pm = pb; pm < M / 256; pm += NP)
                for (int k = 0; k < 4; ++k) pool_diff_unit(PROJ, DD, pm * 4 + k);
            __threadfence(); __builtin_amdgcn_fence(__ATOMIC_ACQUIRE, "agent"); __syncthreads();
            {
                pg8::Gemm g{DD, Wpool_t, PW, 256, 256, 512}; pg8::PanelOrder S{pb, NP, M / 256};
                pg8::Epi<2> E{YB, DM, p.pool_b, p.pool_scale, nullptr};
                pg8::gemm_phase(lds, g, S, E);
            }
        }
        {
            const int tid = opaque_tid(), lane = tid & 63, wave = __builtin_amdgcn_readfirstlane(tid >> 6);
            LAS float* scr = (LAS float*)(lds + wave * 16384);
            constexpr int I_OUT = (DM / 64) * (DM / 32), I_1 = (DM / 64) * (FFW / 32), I_2 = (FFW / 64) * (DM / 32);
            constexpr int QB = 8;
            for (;;) {
                int base = 0;
                if (lane == 0) base = (int)__hip_atomic_fetch_add(qctr, (unsigned)QB, __ATOMIC_RELAXED, __HIP_MEMORY_SCOPE_AGENT);
                base = __builtin_amdgcn_readfirstlane(base);
                if (base >= I_OUT + I_1 + I_2) break;
                for (int it = base; it < base + QB && it < I_OUT + I_1 + I_2; ++it) {
                    int r = it;
                    if (r < I_OUT) { p0_transpose_item(p.w_out, DM, DM, Wout_t, scr, r, lane); continue; } r -= I_OUT;
                    if (r < I_1) { p0_transpose_item(p.w_mlp_in, DM, FFW, W1_t, scr, r, lane, nullptr, p.n_mlp_pre); continue; } r -= I_1;
                    p0_transpose_item(p.w_mlp_out, FFW, DM, W2_t, scr, r, lane);
                }
            }
        }
    }
    SEAM();

#endif
#if (PHMASK>>4)&1
    {
        pg8::Gemm g{YB, Wout_t, DM, DM, DM, 0}; pg8::FusedOrder S{bx, G, M / 256};
        pg8::EpiFused<5> E{nullptr, HN, X1B, nullptr, p.n_mix_post, SSB1, CNT_A, SSB1B, CNT_B, R2, RINV};
        pg8::gemm_phase(lds, g, S, E);
    }
    SEAM();
#endif
#if (PHMASK>>5)&1
#endif
#if (PHMASK>>6)&1
    {
        pg8::Gemm g{X1B, W1_t, DM, DM, DM, 0}; pg8::StaticOrder S; S.init(M, FFW, G, bx);
        pg8::Epi<1> E{FFH, FFW, nullptr, R2, nullptr};
        pg8::gemm_phase(lds, g, S, E);
    }
    SEAM();
    DBG_DUMP(6, FFH, FFW, 0)
#endif
#if (PHMASK>>7)&1
    {
        pg8::Gemm g{FFH, W2_t, FFW, FFW, FFW, 0}; pg8::FusedOrder S{bx, G, M / 256};
        pg8::EpiFused<6> E{nullptr, X1B, nullptr, p.out, p.n_mlp_post, SSB2, CNT_C, nullptr, nullptr, nullptr, nullptr};
        pg8::gemm_phase(lds, g, S, E);
    }
#endif
}

extern "C" void kernel_launch(void* const* d_in, const int* in_sizes, int n_in, void* d_out, int out_size, void* d_ws, size_t ws_size, hipStream_t stream) {
    static int grid_blocks = 0;
    if (grid_blocks == 0) {
        if (n_in != 14 || in_sizes[0] != M * DM || out_size != M * DM || ws_size < WS_END) { fprintf(stderr, "kernel_launch: unexpected shapes (n_in %d, in0 %d, out %d, ws %zu)\n", n_in, n_in > 0 ? in_sizes[0] : -1, out_size, ws_size); grid_blocks = -1; return; }
        int dev = 0, cus = 0, per_cu = 0;
        hipGetDevice(&dev);
        hipDeviceGetAttribute(&cus, hipDeviceAttributeMultiprocessorCount, dev);
        if (hipFuncSetAttribute((const void*)fwd_megakernel, hipFuncAttributeMaxDynamicSharedMemorySize, LDS_BYTES) != hipSuccess) { fprintf(stderr, "kernel_launch: hipFuncSetAttribute failed\n"); grid_blocks = -1; return; }
        if (hipOccupancyMaxActiveBlocksPerMultiprocessor(&per_cu, (const void*)fwd_megakernel, NTHREADS, LDS_BYTES) != hipSuccess || per_cu < 1) { fprintf(stderr, "kernel_launch: occupancy query says %d\n", per_cu); per_cu = 1; }
        (void)hipGetLastError();
        if (per_cu > 1) per_cu = 1;
        grid_blocks = cus * per_cu;
    }
    if (grid_blocks < 0) return;
    Params p{};
    p.x = (const float*)d_in[0]; p.w_in = (const float*)d_in[1]; p.pool_w = (const float*)d_in[2]; p.pool_b = (const float*)d_in[3]; p.pool_scale = (const float*)d_in[4];
    p.lb_logits = (const float*)d_in[5]; p.hgrn_norm_w = (const float*)d_in[6]; p.w_out = (const float*)d_in[7];
    p.n_mix_pre = (const float*)d_in[8]; p.n_mix_post = (const float*)d_in[9]; p.n_mlp_pre = (const float*)d_in[10]; p.n_mlp_post = (const float*)d_in[11];
    p.w_mlp_in = (const float*)d_in[12]; p.w_mlp_out = (const float*)d_in[13];
    p.out = (float*)d_out; p.ws = (unsigned char*)d_ws;
    if (hipMemsetAsync(d_ws, 0, 1u << 20, stream) != hipSuccess) { fprintf(stderr, "kernel_launch: hipMemsetAsync failed\n"); return; }
    void* args[] = {&p};
    hipError_t e = hipLaunchCooperativeKernel((const void*)fwd_megakernel, dim3(grid_blocks), dim3(NTHREADS), args, LDS_BYTES, stream);
    if (e != hipSuccess) fprintf(stderr, "cooperative launch failed: %s (grid %d)\n", hipGetErrorString(e), grid_blocks);
}
```

```cpp
#include <hip/hip_runtime.h>
#include <hip/hip_cooperative_groups.h>
#include <cstdio>
#include <cstdint>
namespace cg = cooperative_groups;

#define LAS __attribute__((address_space(3)))
typedef unsigned short bf16_t;
typedef short bf16x8 __attribute__((ext_vector_type(8)));
typedef float f32x4 __attribute__((ext_vector_type(4)));
typedef float f32x2 __attribute__((ext_vector_type(2)));
typedef unsigned u32x4 __attribute__((ext_vector_type(4)));
typedef unsigned u32x2 __attribute__((ext_vector_type(2)));

constexpr int NB = 16, SEQ = 2048, DM = 2048, M = NB * SEQ;
constexpr int PW = 1024, HW = 1024, INW = PW + 4 * HW, FFW = 4 * DM, NHEAD = 8, HD = 128, CHUNK = 64, NCHUNK = SEQ / CHUNK;
constexpr float EPS = 1e-6f;
constexpr int NTHREADS = 512, NWAVES = 8;
constexpr int LDS_BYTES = 138 * 1024;
constexpr int XCH_OFF = 131072 + 512;

constexpr size_t MiB = 1u << 20;
constexpr size_t WS_WIN = 2 * MiB, WS_WOUT = 22 * MiB, WS_W1 = 30 * MiB, WS_W2 = 62 * MiB, WS_WPOOL = 94 * MiB;
constexpr size_t WS_SS1 = 96 * MiB, WS_SS2 = 100 * MiB;
constexpr size_t WS_BAR = 65536;
constexpr size_t WS_Y = 744 * MiB;
constexpr size_t WS_RINV = 95 * MiB + 512 * 1024;
constexpr size_t WS_R2 = 95 * MiB;
constexpr size_t WS_HN = 104 * MiB;
constexpr size_t WS_MIX = 232 * MiB;
constexpr size_t WS_D = 360 * MiB;
constexpr size_t WS_PROJ = 424 * MiB;
constexpr size_t WS_FFH = 424 * MiB;
constexpr size_t WS_END = 936 * MiB;

typedef __bf16 bf16x2_t __attribute__((ext_vector_type(2)));
__device__ __forceinline__ unsigned cvt_pk_bf16(float lo, float hi) { f32x2 v = {lo, hi}; bf16x2_t b = __builtin_convertvector(v, bf16x2_t); return __builtin_bit_cast(unsigned, b); }
__device__ __forceinline__ float bf_lo(unsigned u) { return __builtin_bit_cast(float, u << 16); }
__device__ __forceinline__ float bf_hi(unsigned u) { return __builtin_bit_cast(float, u & 0xffff0000u); }
__device__ __forceinline__ float wave_sum(float v) {
#pragma unroll
    for (int o = 1; o < 64; o <<= 1) v += __shfl_xor(v, o);
    return v;
}
__device__ __forceinline__ float sigmoidf_(float x) { return __builtin_amdgcn_rcpf(1.0f + __expf(-x)); }
#define LDS_WAIT() asm volatile("s_waitcnt lgkmcnt(0)" ::: "memory")
__device__ __forceinline__ int opaque_tid() { int t = threadIdx.x; asm volatile("" : "+v"(t)); return t; }

namespace pg8 {
constexpr int BM = 256, BK = 64, HALF = 128, HTB = HALF * BK * 2, STAGE_BYTES = 8 * HTB, NXCD = 8, WGM = 8;
__host__ __device__ __forceinline__ int lds_byte(int r, int c) { const int st = (r >> 4) * 2 + (c >> 5), rr = r & 15, cc = c & 31, ob = rr * 64 + cc * 2; return st * 1024 + (ob ^ (((ob >> 9) & 1) << 5)); }
__host__ __device__ __forceinline__ void stage_rc(int b, int& R, int& C) { const int st = b / 1024, sb = b % 1024, swz = sb ^ (((sb >> 9) & 1) << 5); R = (st >> 1) * 16 + swz / 64; C = (st & 1) * 32 + (swz % 64) / 2; }
__host__ __device__ __forceinline__ int perm32(int rho) { const int n = rho >> 4, i = rho & 15; return 8 * (i >> 2) + 4 * n + (i & 3); }

struct Unit { int pm, pn; };
struct Gemm { const bf16_t* A; const bf16_t* Bt; int lda, ldb, K, a_pn_bytes; };

struct StaticOrder {
    int nM, nN, nwg, G, c;
    __device__ void init(int M_, int N_, int G_, int c_) { nM = M_ / BM; nN = N_ / BM; nwg = nM * nN; G = G_; c = c_; }
    __device__ bool next(int i, Unit& u) const {
        const long L = (long)i * G + c; if (L >= nwg) return false;
        int wgid = (int)L; { const int q = nwg / NXCD, r = nwg % NXCD, xcd = wgid % NXCD, off = wgid / NXCD; wgid = (xcd < r ? xcd * (q + 1) : r * (q + 1) + (xcd - r) * q) + off; }
        const int nig = WGM * nN, gid = wgid / nig, fm = gid * WGM, gsz = (nM - fm) < WGM ? (nM - fm) : WGM;
        u.pm = fm + ((wgid % nig) % gsz); u.pn = (wgid % nig) / gsz; return true;
    }
};

struct PanelOrder {
    int pb, NP, nM;
    __device__ bool next(int i, Unit& u) const { const int pm = pb + (i >> 2) * NP; if (pm >= nM) return false; u.pm = pm; u.pn = i & 3; return true; }
};

template <int MODE> struct Epi {
    static constexpr bool FUSED = false;
    bf16_t* O; int ldc; const float* bias; const float* scale; float* ss;
    __device__ __forceinline__ void operator()(const f32x4 (&acc)[2][2][4][2], const Unit& u, int wr, int wc, int fr, int fq) const {
        const int row0 = u.pm * BM + wr * 64 + fr; const int col0 = u.pn * BM + wc * 32 + 8 * fq;
        if (MODE == 4) {
            const int kind = u.pn >> 2;
#pragma unroll
            for (int bj = 0; bj < 2; ++bj) {
                float om[8];
                if (kind == 2) {
                    const int hc = col0 + bj * HALF - (PW + HW);
#pragma unroll
                    for (int e = 0; e < 8; ++e) om[e] = __builtin_amdgcn_rcpf(1.0f + __expf(bias[hc + e] - bias[HW + hc + e]));
                }
#pragma unroll
                for (int ai = 0; ai < 2; ++ai)
#pragma unroll
                    for (int m = 0; m < 4; ++m) {
                        const int row = row0 + ai * HALF + m * 16;
                        f32x4 v0 = acc[ai][bj][m][0], v1 = acc[ai][bj][m][1];
                        if (kind == 2) {
#pragma unroll
                            for (int e = 0; e < 4; ++e) { v0[e] = om[e] * __builtin_amdgcn_rcpf(1.0f + __expf(v0[e])); v1[e] = om[4 + e] * __builtin_amdgcn_rcpf(1.0f + __expf(v1[e])); }
                        } else if (kind == 4) {
#pragma unroll
                            for (int e = 0; e < 4; ++e) { v0[e] = __builtin_amdgcn_rcpf(1.0f + __expf(-v0[e])); v1[e] = __builtin_amdgcn_rcpf(1.0f + __expf(-v1[e])); }
                        }
                        u32x4 w; w.x = cvt_pk_bf16(v0[0], v0[1]); w.y = cvt_pk_bf16(v0[2], v0[3]); w.z = cvt_pk_bf16(v1[0], v1[1]); w.w = cvt_pk_bf16(v1[2], v1[3]);
                        *(u32x4*)(O + (size_t)row * ldc + col0 + bj * HALF) = w;
                    }
            }
            return;
        }
        if (MODE == 2) {
#pragma unroll
            for (int bj = 0; bj < 2; ++bj) {
                const f32x4 b0 = *(const f32x4*)(bias + col0 + bj * HALF) * *(const f32x4*)(scale + col0 + bj * HALF);
                const f32x4 b1 = *(const f32x4*)(bias + col0 + bj * HALF + 4) * *(const f32x4*)(scale + col0 + bj * HALF + 4);
#pragma unroll
                for (int ai = 0; ai < 2; ++ai)
#pragma unroll
                    for (int m = 0; m < 4; ++m) {
                        const int row = row0 + ai * HALF + m * 16;
                        const f32x4 v0 = acc[ai][bj][m][0] + b0, v1 = acc[ai][bj][m][1] + b1;
                        u32x4 w; w.x = cvt_pk_bf16(v0[0], v0[1]); w.y = cvt_pk_bf16(v0[2], v0[3]); w.z = cvt_pk_bf16(v1[0], v1[1]); w.w = cvt_pk_bf16(v1[2], v1[3]);
                        *(u32x4*)(O + (size_t)row * ldc + col0 + bj * HALF) = w;
                    }
            }
            return;
        }
#pragma unroll
        for (int ai = 0; ai < 2; ++ai)
#pragma unroll
            for (int m = 0; m < 4; ++m) {
                const int row = row0 + ai * HALF + m * 16;
                bf16_t* rowp = O + (size_t)row * ldc + col0; float s = 0.f;
                const float rsc = (MODE == 1) ? scale[row] : 1.0f;
#pragma unroll
                for (int bj = 0; bj < 2; ++bj) {
                    f32x4 v0 = acc[ai][bj][m][0], v1 = acc[ai][bj][m][1];
                    if (MODE == 1) {
#pragma unroll
                        for (int e = 0; e < 4; ++e) { float a = fmaxf(v0[e] * rsc, 0.f), b = fmaxf(v1[e] * rsc, 0.f); v0[e] = a * a; v1[e] = b * b; }
                    }
                    if (MODE == 3) { s += (v0[0] * v0[0] + v0[1] * v0[1]) + (v0[2] * v0[2] + v0[3] * v0[3]) + (v1[0] * v1[0] + v1[1] * v1[1]) + (v1[2] * v1[2] + v1[3] * v1[3]); }
                    u32x4 w; w.x = cvt_pk_bf16(v0[0], v0[1]); w.y = cvt_pk_bf16(v0[2], v0[3]); w.z = cvt_pk_bf16(v1[0], v1[1]); w.w = cvt_pk_bf16(v1[2], v1[3]);
                    *(u32x4*)(rowp + bj * HALF) = w;
                }
                if (MODE == 3) { s += __shfl_xor(s, 16); s += __shfl_xor(s, 32); if (fq == 0) ss[(size_t)row * 32 + u.pn * 4 + wc] = s; }
            }
    }
};

struct FusedOrder {
    int c, G, nM;
    __device__ bool next(int i, Unit& u) const { const int x = c & 7, j = c >> 3, pp = G >> 6; const int pm = (i * 8 + x) * pp + (j >> 3); if ((j >> 3) >= pp || pm >= nM) return false; u.pm = pm; u.pn = j & 7; return true; }
};

__device__ __forceinline__ void xst(unsigned* p, float v) { __hip_atomic_store(p, __builtin_bit_cast(unsigned, v), __ATOMIC_RELAXED, __HIP_MEMORY_SCOPE_AGENT); }
__device__ __forceinline__ float xld(unsigned* p) { return __builtin_bit_cast(float, __hip_atomic_load(p, __ATOMIC_RELAXED, __HIP_MEMORY_SCOPE_AGENT)); }

template <int KIND> struct EpiFused {
    static constexpr bool FUSED = true;
    const float* xres; const bf16_t* x1b_in; bf16_t* x1b_out; float* out; const float* gain;
    unsigned* ssb; unsigned* cnt; unsigned* ssb2; unsigned* cnt2; float* r2; const float* rinv;
    __device__ __forceinline__ void operator()(const f32x4 (&acc)[2][2][4][2], const Unit& u, int wr, int wc, int fr, int fq, LAS unsigned char* xl, int tid) const {
        LAS float* P = (LAS float*)xl; LAS float* R = (LAS float*)(xl + 4096); volatile LAS unsigned* flag = (volatile LAS unsigned*)(xl + 5120); LAS float* RI = (LAS float*)(xl + 5184);
        const int prow = u.pm * BM, col0 = u.pn * BM + wc * 32 + 8 * fq;
        u32x4 pb[(KIND == 6) ? 2 : 1][2][4];
#pragma unroll
        for (int bj = 0; bj < ((KIND == 6) ? 2 : 1); ++bj)
#pragma unroll
            for (int ai = 0; ai < 2; ++ai)
#pragma unroll
                for (int m = 0; m < 4; ++m) { const unsigned off = (unsigned)(prow + ai * HALF + wr * 64 + m * 16 + fr) * (unsigned)DM + (unsigned)(col0 + bj * HALF);
                    pb[bj][ai][m] = *(const u32x4*)(x1b_in + off); }
#pragma unroll
        for (int ai = 0; ai < 2; ++ai)
#pragma unroll
            for (int m = 0; m < 4; ++m) {
                float s = 0.f;
#pragma unroll
                for (int bj = 0; bj < 2; ++bj) { const f32x4 v0 = acc[ai][bj][m][0], v1 = acc[ai][bj][m][1];
                    s += (v0[0] * v0[0] + v0[1] * v0[1]) + (v0[2] * v0[2] + v0[3] * v0[3]) + (v1[0] * v1[0] + v1[1] * v1[1]) + (v1[2] * v1[2] + v1[3] * v1[3]); }
                s += __shfl_xor(s, 16); s += __shfl_xor(s, 32);
                if (fq == 0) P[(ai * HALF + wr * 64 + m * 16 + fr) * 4 + wc] = s;
            }
        asm volatile("s_waitcnt lgkmcnt(0)" ::: "memory"); __builtin_amdgcn_s_barrier(); asm volatile("" ::: "memory");
        if (tid < BM) { const f32x4 q = *(const LAS f32x4*)(P + tid * 4); xst(ssb + (size_t)(prow + tid) * 8 + u.pn, (q.x + q.y) + (q.z + q.w)); }
        asm volatile("s_waitcnt vmcnt(0) lgkmcnt(0)" ::: "memory"); __builtin_amdgcn_s_barrier(); asm volatile("" ::: "memory");
        if (tid == 0) {
            unsigned* cw = cnt + u.pm * 16;
            (void)__hip_atomic_fetch_add(cw, 1u, __ATOMIC_RELAXED, __HIP_MEMORY_SCOPE_AGENT);
            unsigned sp = 0;
            while (__hip_atomic_load(cw, __ATOMIC_RELAXED, __HIP_MEMORY_SCOPE_AGENT) < 8u) { __builtin_amdgcn_s_sleep(1); if (++sp > (1u << 22)) break; }
            __builtin_amdgcn_fence(__ATOMIC_ACQUIRE, "agent");
        }
        asm volatile("s_waitcnt vmcnt(0) lgkmcnt(0)" ::: "memory"); __builtin_amdgcn_s_barrier(); asm volatile("" ::: "memory");
        if (tid < BM) { unsigned* sp8 = ssb + (size_t)(prow + tid) * 8; float s = 0.f;
#pragma unroll
            for (int k = 0; k < 8; ++k) s += xld(sp8 + k);
            R[tid] = rsqrtf(s * (1.0f / DM) + EPS); RI[tid] = (KIND == 5) ? rinv[prow + tid] : 1.0f; }
        asm volatile("s_waitcnt vmcnt(0) lgkmcnt(0)" ::: "memory"); __builtin_amdgcn_s_barrier(); asm volatile("" ::: "memory");
#pragma unroll
        for (int bj = 0; bj < 2; ++bj) {
            const f32x4 g0 = *(const f32x4*)(gain + col0 + bj * HALF), g1 = *(const f32x4*)(gain + col0 + bj * HALF + 4);
            if (KIND == 5 && bj == 1) {
#pragma unroll
                for (int ai = 0; ai < 2; ++ai)
#pragma unroll
                    for (int m = 0; m < 4; ++m) { const unsigned off = (unsigned)(prow + ai * HALF + wr * 64 + m * 16 + fr) * (unsigned)DM + (unsigned)(col0 + HALF);
                        pb[0][ai][m] = *(const u32x4*)(x1b_in + off); }
            }
#pragma unroll
            for (int ai = 0; ai < 2; ++ai) {
                float s2q[4] = {0.f, 0.f, 0.f, 0.f};
#pragma unroll
                for (int m = 0; m < 4; ++m) {
                    const int lrow = ai * HALF + wr * 64 + m * 16 + fr;
                    const unsigned off = (unsigned)(prow + lrow) * (unsigned)DM + (unsigned)(col0 + bj * HALF);
                    const float rr = R[lrow];
                    f32x4 a0, a1;
                    { const u32x4 xb = pb[(KIND == 6) ? bj : 0][ai][m]; a0 = (f32x4){bf_lo(xb.x), bf_hi(xb.x), bf_lo(xb.y), bf_hi(xb.y)}; a1 = (f32x4){bf_lo(xb.z), bf_hi(xb.z), bf_lo(xb.w), bf_hi(xb.w)}; }
                    if (KIND == 5) { const float ri = RI[lrow]; a0 = a0 * ri; a1 = a1 * ri; }
                    const f32x4 v0 = a0 + acc[ai][bj][m][0] * rr * g0, v1 = a1 + acc[ai][bj][m][1] * rr * g1;
                    if (KIND == 5) {
                        u32x4 w; w.x = cvt_pk_bf16(v0[0], v0[1]); w.y = cvt_pk_bf16(v0[2], v0[3]); w.z = cvt_pk_bf16(v1[0], v1[1]); w.w = cvt_pk_bf16(v1[2], v1[3]);
                        *(u32x4*)(x1b_out + off) = w;
                        s2q[m] += (v0[0] * v0[0] + v0[1] * v0[1]) + (v0[2] * v0[2] + v0[3] * v0[3]) + (v1[0] * v1[0] + v1[1] * v1[1]) + (v1[2] * v1[2] + v1[3] * v1[3]);
                    } else { *(f32x4*)(out + off) = v0; *(f32x4*)(out + off + 4) = v1; }
                }
                if (KIND == 5) {
#pragma unroll
                    for (int m = 0; m < 4; ++m) { float t2 = s2q[m]; t2 += __shfl_xor(t2, 16); t2 += __shfl_xor(t2, 32);
                        if (fq == 0) { LAS float* pp = P + (ai * HALF + wr * 64 + m * 16 + fr) * 4 + wc; if (bj == 0) *pp = t2; else *pp += t2; } }
                }
                asm volatile("" ::: "memory");
            }
        }
        if (KIND == 5) {
            asm volatile("s_waitcnt lgkmcnt(0)" ::: "memory"); __builtin_amdgcn_s_barrier(); asm volatile("" ::: "memory");
            if (tid < BM) { const f32x4 q = *(const LAS f32x4*)(P + tid * 4); xst(ssb2 + (size_t)(prow + tid) * 8 + u.pn, (q.x + q.y) + (q.z + q.w)); }
            asm volatile("s_waitcnt vmcnt(0) lgkmcnt(0)" ::: "memory"); __builtin_amdgcn_s_barrier(); asm volatile("" ::: "memory");
            if (tid == 0) flag[0] = __hip_atomic_fetch_add(cnt2 + u.pm * 16, 1u, __ATOMIC_RELAXED, __HIP_MEMORY_SCOPE_AGENT);
            asm volatile("s_waitcnt vmcnt(0) lgkmcnt(0)" ::: "memory"); __builtin_amdgcn_s_barrier(); asm volatile("" ::: "memory");
            if (flag[0] == 7u && tid < BM) { unsigned* sp8 = ssb2 + (size_t)(prow + tid) * 8; float s = 0.f;
#pragma unroll
                for (int k = 0; k < 8; ++k) s += xld(sp8 + k);
                r2[prow + tid] = rsqrtf(s * (1.0f / DM) + EPS); }
            asm volatile("s_waitcnt lgkmcnt(0)" ::: "memory"); __builtin_amdgcn_s_barrier(); asm volatile("" ::: "memory");
        }
    }
};

template <class EpiT, class Sched>
__device__ __forceinline__ void gemm_phase(LAS unsigned char* lds, const Gemm g, const Sched& S, const EpiT& E) {
    int tid_ = threadIdx.x; asm volatile("" : "+v"(tid_));
    const int tid = tid_, wid = __builtin_amdgcn_readfirstlane(tid >> 6), lane = tid & 63, wr = wid >> 2, wc = wid & 3, fr = lane & 15, fq = lane >> 4;
    const int K = g.K, nt = K / BK;
    unsigned voffA[2], voffB[2];
#pragma unroll
    for (int i = 0; i < 2; ++i) { int R, C; stage_rc(tid * 16 + i * 8192, R, C); const int Rb = (R & ~31) + perm32(R & 31);
        voffA[i] = (unsigned)(R * g.lda + C) * 2u; voffB[i] = (unsigned)(Rb * g.ldb + C) * 2u; }
    const size_t kstep = (size_t)(BK * 2);
    const size_t hstepA = (size_t)HALF * g.lda * 2, hstepB = (size_t)HALF * g.ldb * 2;
    const size_t tstepA = 2 * hstepA, tstepB = 2 * hstepB;
    const unsigned ldsw = (unsigned)wid * 1024u;
    const int aoff = lds_byte(wr * 64 + fr, fq * 8), boff = lds_byte(wc * 32 + fr, fq * 8);
#define PG8_SA(b, h) (((b) * 2 + (h)) * HTB)
#define PG8_SB(b, h) ((4 + (b) * 2 + (h)) * HTB)
#define PG8_STAGE(bufoff, gbase, voff) do { _Pragma("unroll") for (int _i = 0; _i < 2; ++_i) \
        __builtin_amdgcn_global_load_lds((const unsigned*)((const char*)(gbase) + (voff)[_i]), (LAS unsigned*)(lds + (bufoff) + ldsw + _i * 8192), 16, 0, 0); } while (0)
#define PG8_LDA(dst, b, h) do { _Pragma("unroll") for (int m = 0; m < 4; ++m) _Pragma("unroll") for (int k = 0; k < 2; ++k) dst[m][k] = *(const LAS bf16x8*)(lds + PG8_SA(b, h) + aoff + m * 2048 + k * 1024); } while (0)
#define PG8_LDB(dst, b, h) do { _Pragma("unroll") for (int n = 0; n < 2; ++n) _Pragma("unroll") for (int k = 0; k < 2; ++k) dst[n][k] = *(const LAS bf16x8*)(lds + PG8_SB(b, h) + boff + n * 2048 + k * 1024); } while (0)
#define PG8_MMA(ai, bj, At, Bt) do { __builtin_amdgcn_s_setprio(1); _Pragma("unroll") for (int m = 0; m < 4; ++m) _Pragma("unroll") for (int n = 0; n < 2; ++n) _Pragma("unroll") for (int k = 0; k < 2; ++k) \
        acc[ai][bj][m][n] = __builtin_amdgcn_mfma_f32_16x16x32_bf16(Bt[n][k], At[m][k], acc[ai][bj][m][n], 0, 0, 0); __builtin_amdgcn_s_setprio(0); } while (0)
#define PG8_WAIT_V(n) asm volatile("s_waitcnt vmcnt(" #n ")" ::: "memory")
#define PG8_WAIT_L(n) asm volatile("s_waitcnt lgkmcnt(" #n ")" ::: "memory")
#define PG8_BAR __builtin_amdgcn_s_barrier()
#define PG8_SCHED __builtin_amdgcn_sched_barrier(0)
    Unit cur, nxt; int ui = 0;
    if (!S.next(0, cur)) return;
    f32x4 acc[2][2][4][2];
#pragma unroll
    for (int a = 0; a < 2; ++a)
#pragma unroll
        for (int b = 0; b < 2; ++b)
#pragma unroll
            for (int m = 0; m < 4; ++m)
#pragma unroll
                for (int n = 0; n < 2; ++n) acc[a][b][m][n] = (f32x4){0.f, 0.f, 0.f, 0.f};
    bf16x8 At[4][2], B0[2][2], B1[2][2];
    const char* cA = (const char*)g.A + (size_t)cur.pm * tstepA + (size_t)cur.pn * g.a_pn_bytes; const char* cB = (const char*)g.Bt + (size_t)cur.pn * tstepB;
    PG8_STAGE(PG8_SB(0, 0), cB, voffB); PG8_STAGE(PG8_SB(0, 1), cB + hstepB, voffB); PG8_STAGE(PG8_SA(0, 0), cA, voffA); PG8_STAGE(PG8_SA(0, 1), cA + hstepA, voffA);
    if (wr == 1) PG8_BAR;
    PG8_WAIT_V(2); PG8_BAR;
    PG8_STAGE(PG8_SB(1, 0), cB + kstep, voffB); PG8_STAGE(PG8_SA(1, 0), cA + kstep, voffA); PG8_STAGE(PG8_SB(1, 1), cB + hstepB + kstep, voffB);
    PG8_WAIT_V(6); PG8_BAR;
    for (;;) {
        const bool has_next = S.next(ui + 1, nxt);
        const char* nA = has_next ? (const char*)g.A + (size_t)nxt.pm * tstepA + (size_t)nxt.pn * g.a_pn_bytes : cA; const char* nB = has_next ? (const char*)g.Bt + (size_t)nxt.pn * tstepB : cB;
#pragma nounroll
        for (int t = 0; t < nt; t += 2) {
            const bool last = (t == nt - 2);
            const char* a1 = cA + (size_t)(t + 1) * kstep;
            const char* a2 = last ? nA : cA + (size_t)(t + 2) * kstep; const char* b2 = last ? nB : cB + (size_t)(t + 2) * kstep;
            const char* a3 = a2 + kstep; const char* b3 = b2 + kstep;
            PG8_LDB(B0, 0, 0); PG8_LDB(B1, 0, 1); PG8_SCHED; PG8_LDA(At, 0, 0); PG8_STAGE(PG8_SA(1, 1), a1 + hstepA, voffA);
            PG8_WAIT_V(8); PG8_WAIT_L(0); PG8_BAR; PG8_MMA(0, 0, At, B0); PG8_MMA(0, 1, At, B1); PG8_BAR; PG8_SCHED;
            PG8_LDA(At, 0, 1); PG8_STAGE(PG8_SB(0, 0), b2, voffB); PG8_STAGE(PG8_SB(0, 1), b2 + hstepB, voffB); PG8_STAGE(PG8_SA(0, 0), a2, voffA);
            PG8_WAIT_V(8); PG8_WAIT_L(0); PG8_BAR; PG8_MMA(1, 0, At, B0); PG8_MMA(1, 1, At, B1); PG8_BAR; PG8_SCHED;
            PG8_LDB(B0, 1, 0); PG8_LDB(B1, 1, 1); PG8_SCHED; PG8_LDA(At, 1, 0); PG8_STAGE(PG8_SA(0, 1), a2 + hstepA, voffA);
            PG8_WAIT_V(8); PG8_WAIT_L(0); PG8_BAR; PG8_MMA(0, 0, At, B0); PG8_MMA(0, 1, At, B1); PG8_BAR; PG8_SCHED;
            PG8_LDA(At, 1, 1); PG8_STAGE(PG8_SB(1, 0), b3, voffB); PG8_STAGE(PG8_SB(1, 1), b3 + hstepB, voffB); PG8_STAGE(PG8_SA(1, 0), a3, voffA);
            PG8_WAIT_V(8); PG8_WAIT_L(0); PG8_BAR; PG8_MMA(1, 0, At, B0); PG8_MMA(1, 1, At, B1); PG8_BAR; PG8_SCHED;
        }
        if (wr == 0) PG8_BAR;
        if constexpr (EpiT::FUSED) E(acc, cur, wr, wc, fr, fq, lds + XCH_OFF, tid); else E(acc, cur, wr, wc, fr, fq);
        if (!has_next) break;
#pragma unroll
        for (int a = 0; a < 2; ++a)
#pragma unroll
            for (int b = 0; b < 2; ++b)
#pragma unroll
                for (int m = 0; m < 4; ++m)
#pragma unroll
                    for (int n = 0; n < 2; ++n) acc[a][b][m][n] = (f32x4){0.f, 0.f, 0.f, 0.f};
        cur = nxt; cA = nA; cB = nB; ++ui;
        if (wr == 1) PG8_BAR;
    }
    PG8_WAIT_V(0);
    PG8_BAR;
#undef PG8_SA
#undef PG8_SB
#undef PG8_STAGE
#undef PG8_LDA
#undef PG8_LDB
#undef PG8_MMA
#undef PG8_WAIT_V
#undef PG8_WAIT_L
#undef PG8_BAR
#undef PG8_SCHED
}
}

__device__ __forceinline__ void p0_transpose_item(const float* W, int K, int N, bf16_t* WT, LAS float* scr, int item, int lane, const float* colscale = nullptr, const float* rowscale = nullptr) {
    const int nblk = N / 32, kb = item / nblk, nb = item % nblk, k0 = 64 * kb, n0 = 32 * nb;
    const int lr = lane >> 3, lc = (lane & 7) * 4;
    f32x4 v[8];
#pragma unroll
    for (int i = 0; i < 8; ++i) v[i] = __builtin_nontemporal_load((const f32x4*)(W + (size_t)(k0 + lr + 8 * i) * N + n0 + lc));
    f32x4 cs = (f32x4){1.f, 1.f, 1.f, 1.f};
    if (colscale) cs = *(const f32x4*)(colscale + n0 + lc);
#pragma unroll
    for (int i = 0; i < 8; ++i) { const int kk = lr + 8 * i; const float rs = rowscale ? rowscale[k0 + kk] : 1.0f; const f32x4 t = v[i] * cs * rs;
        LAS float* d = scr + kk * 33 + lc; d[0] = t.x; d[1] = t.y; d[2] = t.z; d[3] = t.w; }
    LDS_WAIT(); asm volatile("" ::: "memory");
    const int c = lane & 7;
#pragma unroll
    for (int j = 0; j < 4; ++j) { const int n = (lane >> 3) + 8 * j; const LAS float* s = scr + (8 * c) * 33 + n;
        u32x4 o; o.x = cvt_pk_bf16(s[0 * 33], s[1 * 33]); o.y = cvt_pk_bf16(s[2 * 33], s[3 * 33]); o.z = cvt_pk_bf16(s[4 * 33], s[5 * 33]); o.w = cvt_pk_bf16(s[6 * 33], s[7 * 33]);
        *(u32x4*)(WT + (size_t)(n0 + n) * K + k0 + 8 * c) = o; }
    LDS_WAIT(); asm volatile("" ::: "memory");
}

template <int R>
__device__ __forceinline__ void rms_rows_to_bf16(const float* x, float* rinv, bf16_t* o, int m0, int mstride, int lane) {
    f32x4 v[R][8];
#pragma unroll
    for (int r = 0; r < R; ++r) { const f32x4* xr = (const f32x4*)(x + (size_t)(m0 + r * mstride) * DM) + lane;
#pragma unroll
        for (int j = 0; j < 8; ++j) v[r][j] = xr[64 * j]; }
#pragma unroll
    for (int r = 0; r < R; ++r) {
        float s = 0.f;
#pragma unroll
        for (int j = 0; j < 8; ++j) s += (v[r][j].x * v[r][j].x + v[r][j].y * v[r][j].y) + (v[r][j].z * v[r][j].z + v[r][j].w * v[r][j].w);
        const float ms = wave_sum(s) * (1.f / DM) + EPS; const float rr = rsqrtf(ms);
        if (lane == 0) rinv[m0 + r * mstride] = sqrtf(ms);
        u32x2* o8 = (u32x2*)(o + (size_t)(m0 + r * mstride) * DM) + lane;
#pragma unroll
        for (int j = 0; j < 8; ++j) { u32x2 ob; ob.x = cvt_pk_bf16(v[r][j].x * rr, v[r][j].y * rr); ob.y = cvt_pk_bf16(v[r][j].z * rr, v[r][j].w * rr); o8[64 * j] = ob; }
    }
}

constexpr int H_QD = 0, H_KT = 17408, H_KDT = 34816, H_VT = 53248, H_ST = 71680, H_PP = 106496, H_SEG = 115712, H_EL = 119808;
constexpr int PITCH_T = 272;
constexpr int PITCH_S = 144;
#define MFMA16(a, b, c) __builtin_amdgcn_mfma_f32_16x16x32_bf16((a), (b), (c), 0, 0, 0)
#define HSYNC() do { asm volatile("s_waitcnt lgkmcnt(0)" ::: "memory"); __builtin_amdgcn_s_barrier(); asm volatile("" ::: "memory"); } while (0)

__device__ __forceinline__ void hgrn_unit(LAS unsigned char* lds, const bf16_t* proj, bf16_t* Y, const float* hnw, int bh) {
    const int tid = opaque_tid(), w = __builtin_amdgcn_readfirstlane(tid >> 6), lane = tid & 63, fr = lane & 15, fq = lane >> 4;
    const int b = bh >> 3, h = bh & 7;
    const unsigned* P32 = (const unsigned*)proj;
    const size_t rowbase = (size_t)b * SEQ + 8 * w;
    const int cq = (PW + h * HD) / 2 + lane, cf = (PW + HW + h * HD) / 2 + lane, cv = (PW + 2 * HW + h * HD) / 2 + lane;
    const int orow = lane >> 3, oseg = lane & 7;
    const u32x4* P128 = (const u32x4*)proj;
    const int cg16 = (PW + 3 * HW + h * HD) / 8 + 2 * oseg;
    u32x4* Y128 = (u32x4*)Y;
    const int cy16 = (PW + h * HD) / 8 + 2 * oseg;
    float nw[16];
#pragma unroll
    for (int j = 0; j < 16; ++j) nw[j] = hnw[h * HD + 16 * oseg + j];

    f32x4 S[2][4];
#pragma unroll
    for (int di = 0; di < 2; ++di)
#pragma unroll
        for (int ej = 0; ej < 4; ++ej) S[di][ej] = (f32x4){0.f, 0.f, 0.f, 0.f};
    const int dt0 = 2 * (w >> 1), et0 = 4 * (w & 1);
#pragma unroll
    for (int di = 0; di < 2; ++di)
#pragma unroll
        for (int ej = 0; ej < 4; ++ej) *(LAS u32x2*)(lds + H_ST + (16 * (et0 + ej) + fr) * PITCH_T + (16 * (dt0 + di) + 4 * fq) * 2) = (u32x2){0u, 0u};

    unsigned rq[8], rf[8], rv[8]; u32x4 rg0, rg1, ng0, ng1;
#pragma unroll
    for (int i = 0; i < 8; ++i) { const size_t r = (rowbase + i) * (INW / 2); rq[i] = P32[r + cq]; rf[i] = P32[r + cf]; rv[i] = P32[r + cv]; }
    { const size_t r = (rowbase + orow) * (INW / 8); rg0 = P128[r + cg16]; rg1 = P128[r + cg16 + 1]; }

    for (int c = 0; c < NCHUNK; ++c) {
        float kk[8][2], bl[8][2]; float cum0 = 1.f, cum1 = 1.f;
#pragma unroll
        for (int i = 0; i < 8; ++i) {
            kk[i][0] = bf_lo(rf[i]); kk[i][1] = bf_hi(rf[i]);
            cum0 *= 1.0f - kk[i][0]; cum1 *= 1.0f - kk[i][1];
            bl[i][0] = cum0; bl[i][1] = cum1;
        }
        *(LAS f32x2*)(lds + H_SEG + (w * 128 + 2 * lane) * 4) = (f32x2){cum0, cum1};
        HSYNC();
        float pre0 = 1.f, pre1 = 1.f, tot0 = 1.f, tot1 = 1.f;
#pragma unroll
        for (int ww = 0; ww < 8; ++ww) { const f32x2 sgv = *(const LAS f32x2*)(lds + H_SEG + (ww * 128 + 2 * lane) * 4); tot0 *= sgv.x; tot1 *= sgv.y; if (ww < w) { pre0 *= sgv.x; pre1 *= sgv.y; } }
        unsigned kd0[4], kd1[4], vt0[4], vt1[4];
#pragma unroll
        for (int i = 0; i < 8; ++i) {
            const float p0 = fmaxf(pre0 * bl[i][0], 1e-30f), p1 = fmaxf(pre1 * bl[i][1], 1e-30f);
            const float q0 = bf_lo(rq[i]) * p0, q1 = bf_hi(rq[i]) * p1;
            const float k0 = kk[i][0] * __builtin_amdgcn_rcpf(p0), k1 = kk[i][1] * __builtin_amdgcn_rcpf(p1);
            const float e0 = k0 * tot0, e1 = k1 * tot1;
            const int t = 8 * w + i;
            *(LAS unsigned*)(lds + H_QD + t * PITCH_T + lane * 4) = cvt_pk_bf16(q0, q1);
            *(LAS unsigned*)(lds + H_KT + t * PITCH_T + lane * 4) = cvt_pk_bf16(k0, k1);
            const unsigned ep = cvt_pk_bf16(e0, e1);
            if (i & 1) { kd0[i >> 1] |= ep << 16; kd1[i >> 1] |= ep & 0xffff0000u; vt0[i >> 1] |= rv[i] << 16; vt1[i >> 1] |= rv[i] & 0xffff0000u; }
            else { kd0[i >> 1] = ep & 0xffffu; kd1[i >> 1] = ep >> 16; vt0[i >> 1] = rv[i] & 0xffffu; vt1[i >> 1] = rv[i] >> 16; }
        }
        *(LAS u32x4*)(lds + H_KDT + (2 * lane) * PITCH_S + 16 * w) = (u32x4){kd0[0], kd0[1], kd0[2], kd0[3]};
        *(LAS u32x4*)(lds + H_KDT + (2 * lane + 1) * PITCH_S + 16 * w) = (u32x4){kd1[0], kd1[1], kd1[2], kd1[3]};
        *(LAS u32x4*)(lds + H_VT + (2 * lane) * PITCH_S + 16 * w) = (u32x4){vt0[0], vt0[1], vt0[2], vt0[3]};
        *(LAS u32x4*)(lds + H_VT + (2 * lane + 1) * PITCH_S + 16 * w) = (u32x4){vt1[0], vt1[1], vt1[2], vt1[3]};
        if (w == 0) *(LAS f32x2*)(lds + H_EL + lane * 8) = (f32x2){tot0, tot1};
        if (c + 1 < NCHUNK) {
#pragma unroll
            for (int i = 0; i < 8; ++i) { const size_t r = (rowbase + (size_t)(c + 1) * CHUNK + i) * (INW / 2); rq[i] = P32[r + cq]; rf[i] = P32[r + cf]; rv[i] = P32[r + cv]; }
            const size_t r = (rowbase + (size_t)(c + 1) * CHUNK + orow) * (INW / 8); ng0 = P128[r + cg16]; ng1 = P128[r + cg16 + 1];
        }
        HSYNC();
        {
            const int si = w >> 1;
#pragma unroll
            for (int tt = 0; tt < 2; ++tt) {
                const int ti = 2 * (w & 1) + tt;
                f32x4 a = (f32x4){0.f, 0.f, 0.f, 0.f};
                if (si <= ti) {
#pragma unroll
                    for (int ks = 0; ks < 4; ++ks) {
                        const bf16x8 A = *(const LAS bf16x8*)(lds + H_KT + (16 * si + fr) * PITCH_T + (8 * fq + 32 * ks) * 2);
                        const bf16x8 B = *(const LAS bf16x8*)(lds + H_QD + (16 * ti + fr) * PITCH_T + (8 * fq + 32 * ks) * 2);
                        a = MFMA16(A, B, a);
                    }
                    if (si == ti) {
#pragma unroll
                        for (int r = 0; r < 4; ++r) if (4 * fq + r > fr) a[r] = 0.f;
                    }
                }
                *(LAS u32x2*)(lds + H_PP + (16 * ti + fr) * PITCH_S + (16 * si + 4 * fq) * 2) = (u32x2){cvt_pk_bf16(a[0], a[1]), cvt_pk_bf16(a[2], a[3])};
            }
        }
        HSYNC();
        {
            f32x4 o[4];
#pragma unroll
            for (int ti = 0; ti < 4; ++ti) o[ti] = (f32x4){0.f, 0.f, 0.f, 0.f};
#pragma unroll
            for (int ks = 0; ks < 4; ++ks) {
                const bf16x8 A = *(const LAS bf16x8*)(lds + H_ST + (16 * w + fr) * PITCH_T + (8 * fq + 32 * ks) * 2);
#pragma unroll
                for (int ti = 0; ti < 4; ++ti) { const bf16x8 B = *(const LAS bf16x8*)(lds + H_QD + (16 * ti + fr) * PITCH_T + (8 * fq + 32 * ks) * 2); o[ti] = MFMA16(A, B, o[ti]); }
            }
#pragma unroll
            for (int ks = 0; ks < 2; ++ks) {
                const bf16x8 A = *(const LAS bf16x8*)(lds + H_VT + (16 * w + fr) * PITCH_S + (8 * fq + 32 * ks) * 2);
#pragma unroll
                for (int ti = 0; ti < 4; ++ti) { const bf16x8 B = *(const LAS bf16x8*)(lds + H_PP + (16 * ti + fr) * PITCH_S + (8 * fq + 32 * ks) * 2); o[ti] = MFMA16(A, B, o[ti]); }
            }
#pragma unroll
            for (int ti = 0; ti < 4; ++ti) *(LAS u32x2*)(lds + H_KT + (16 * ti + fr) * PITCH_T + (16 * w + 4 * fq) * 2) = (u32x2){cvt_pk_bf16(o[ti][0], o[ti][1]), cvt_pk_bf16(o[ti][2], o[ti][3])};
        }
        {
#pragma unroll
            for (int di = 0; di < 2; ++di) {
                const f32x4 el = *(const LAS f32x4*)(lds + H_EL + (16 * (dt0 + di) + 4 * fq) * 4);
#pragma unroll
                for (int ej = 0; ej < 4; ++ej) S[di][ej] = S[di][ej] * el;
            }
#pragma unroll
            for (int ks = 0; ks < 2; ++ks) {
                bf16x8 A[2], B[4];
#pragma unroll
                for (int di = 0; di < 2; ++di) A[di] = *(const LAS bf16x8*)(lds + H_KDT + (16 * (dt0 + di) + fr) * PITCH_S + (8 * fq + 32 * ks) * 2);
#pragma unroll
                for (int ej = 0; ej < 4; ++ej) B[ej] = *(const LAS bf16x8*)(lds + H_VT + (16 * (et0 + ej) + fr) * PITCH_S + (8 * fq + 32 * ks) * 2);
#pragma unroll
                for (int di = 0; di < 2; ++di)
#pragma unroll
                    for (int ej = 0; ej < 4; ++ej) S[di][ej] = MFMA16(A[di], B[ej], S[di][ej]);
            }
        }
        HSYNC();
#pragma unroll
        for (int di = 0; di < 2; ++di)
#pragma unroll
            for (int ej = 0; ej < 4; ++ej)
                *(LAS u32x2*)(lds + H_ST + (16 * (et0 + ej) + fr) * PITCH_T + (16 * (dt0 + di) + 4 * fq) * 2) = (u32x2){cvt_pk_bf16(S[di][ej][0], S[di][ej][1]), cvt_pk_bf16(S[di][ej][2], S[di][ej][3])};
        {
            const u32x4 oa = *(const LAS u32x4*)(lds + H_KT + (8 * w + orow) * PITCH_T + oseg * 32);
            const u32x4 ob = *(const LAS u32x4*)(lds + H_KT + (8 * w + orow) * PITCH_T + oseg * 32 + 16);
            const unsigned ou[8] = {oa.x, oa.y, oa.z, oa.w, ob.x, ob.y, ob.z, ob.w};
            const unsigned gu[8] = {rg0.x, rg0.y, rg0.z, rg0.w, rg1.x, rg1.y, rg1.z, rg1.w};
            float gv[16]; float ssq = 0.f;
#pragma unroll
            for (int j = 0; j < 8; ++j) { gv[2 * j] = bf_lo(ou[j]) * bf_lo(gu[j]); gv[2 * j + 1] = bf_hi(ou[j]) * bf_hi(gu[j]); ssq += gv[2 * j] * gv[2 * j] + gv[2 * j + 1] * gv[2 * j + 1]; }
            ssq += __shfl_xor(ssq, 1); ssq += __shfl_xor(ssq, 2); ssq += __shfl_xor(ssq, 4);
            const float r = rsqrtf(ssq * (1.0f / HD) + EPS);
            u32x4 y0, y1;
            y0.x = cvt_pk_bf16(gv[0] * r * nw[0], gv[1] * r * nw[1]); y0.y = cvt_pk_bf16(gv[2] * r * nw[2], gv[3] * r * nw[3]);
            y0.z = cvt_pk_bf16(gv[4] * r * nw[4], gv[5] * r * nw[5]); y0.w = cvt_pk_bf16(gv[6] * r * nw[6], gv[7] * r * nw[7]);
            y1.x = cvt_pk_bf16(gv[8] * r * nw[8], gv[9] * r * nw[9]); y1.y = cvt_pk_bf16(gv[10] * r * nw[10], gv[11] * r * nw[11]);
            y1.z = cvt_pk_bf16(gv[12] * r * nw[12], gv[13] * r * nw[13]); y1.w = cvt_pk_bf16(gv[14] * r * nw[14], gv[15] * r * nw[15]);
            const size_t yr = (rowbase + (size_t)c * CHUNK + orow) * (DM / 8);
            Y128[yr + cy16] = y0; Y128[yr + cy16 + 1] = y1;
        }
        rg0 = ng0; rg1 = ng1;
    }
    __syncthreads();
}

__device__ __forceinline__ void pool_diff_unit(const bf16_t* proj, bf16_t* D, int unit) {
    const int tid = opaque_tid(), tq = tid >> 7, cgp = tid & 127;
    const int b = unit >> 5, tc = unit & 31;
    const int j = cgp >> 5, win = 2 << j;
    const int t0 = tc * 64 + tq * 16;
    const u32x4* P = (const u32x4*)proj + (size_t)b * SEQ * (INW / 8) + cgp;
    u32x4 row[32];
#pragma unroll
    for (int r = 0; r < 32; ++r) { const int t = t0 - 16 + r; row[r] = (t >= 0) ? P[(size_t)t * (INW / 8)] : (u32x4){0u, 0u, 0u, 0u}; }
    float sum[8];
#pragma unroll
    for (int e = 0; e < 8; ++e) sum[e] = 0.f;
#pragma unroll
    for (int k = 1; k <= 16; ++k) {
        const float mk = (k <= win) ? 1.f : 0.f; const u32x4 v = row[16 - k];
        sum[0] += mk * bf_lo(v.x); sum[1] += mk * bf_hi(v.x); sum[2] += mk * bf_lo(v.y); sum[3] += mk * bf_hi(v.y);
        sum[4] += mk * bf_lo(v.z); sum[5] += mk * bf_hi(v.z); sum[6] += mk * bf_lo(v.w); sum[7] += mk * bf_hi(v.w);
    }
    const float invw = (j == 0) ? 0.5f : (j == 1) ? 0.25f : (j == 2) ? 0.125f : 0.0625f;
    u32x4* Dp = (u32x4*)D + ((size_t)b * SEQ + t0) * (PW / 8) + cgp;
#pragma unroll
    for (int i = 0; i < 16; ++i) {
        const u32x4 v = row[16 + i];
        const u32x4 a = row[16 + i - 2], bq = row[16 + i - 4], cq = row[16 + i - 8], dq = row[i];
        u32x4 o;
        o.x = (j == 0) ? a.x : (j == 1) ? bq.x : (j == 2) ? cq.x : dq.x; o.y = (j == 0) ? a.y : (j == 1) ? bq.y : (j == 2) ? cq.y : dq.y;
        o.z = (j == 0) ? a.z : (j == 1) ? bq.z : (j == 2) ? cq.z : dq.z; o.w = (j == 0) ? a.w : (j == 1) ? bq.w : (j == 2) ? cq.w : dq.w;
        const float u[8] = {bf_lo(v.x), bf_hi(v.x), bf_lo(v.y), bf_hi(v.y), bf_lo(v.z), bf_hi(v.z), bf_lo(v.w), bf_hi(v.w)};
        const float ov[8] = {bf_lo(o.x), bf_hi(o.x), bf_lo(o.y), bf_hi(o.y), bf_lo(o.z), bf_hi(o.z), bf_lo(o.w), bf_hi(o.w)};
#pragma unroll
        for (int e = 0; e < 8; ++e) sum[e] += u[e] - ov[e];
        const int t = t0 + i;
        const float inv = (t + 1 >= win) ? invw : __builtin_amdgcn_rcpf((float)(t + 1));
        u32x4 d; d.x = cvt_pk_bf16(sum[0] * inv - u[0], sum[1] * inv - u[1]); d.y = cvt_pk_bf16(sum[2] * inv - u[2], sum[3] * inv - u[3]);
        d.z = cvt_pk_bf16(sum[4] * inv - u[4], sum[5] * inv - u[5]); d.w = cvt_pk_bf16(sum[6] * inv - u[6], sum[7] * inv - u[7]);
        Dp[(size_t)i * (PW / 8)] = d;
    }
}

#define XB_TMO      128
#define XB_XCNT(j)  (256  + 64 * (j))
#define XB_XSUB(j)  (1280 + 64 * (j))
#define XB_XGEN(j)  (2304 + 64 * (j))
#define XB_TOP      3328
#define XB_TOPGEN   3392
#define XCD_BAR_WORDS 3456
#define XB_SPIN_CAP (1u << 18)

__device__ __forceinline__ unsigned xb_ld(unsigned* p)              { return __hip_atomic_load(p, __ATOMIC_RELAXED, __HIP_MEMORY_SCOPE_AGENT); }
__device__ __forceinline__ unsigned xb_add(unsigned* p, unsigned v) { return __hip_atomic_fetch_add(p, v, __ATOMIC_RELAXED, __HIP_MEMORY_SCOPE_AGENT); }
__device__ __forceinline__ unsigned xb_xcc_id() { return (unsigned)__builtin_amdgcn_s_getreg((3 << 11) | 20) & 0xFu; }
#define XB_SPIN(cond, bar) do { unsigned _sp = 0; while (cond) { __builtin_amdgcn_s_sleep(1); \
    if ((++_sp & 255u) == 0u) { if (xb_ld(&(bar)[XB_TMO])) break; if (_sp > XB_SPIN_CAP) { atomicAdd(&(bar)[XB_TMO], 1u); break; } } } } while (0)

struct XcdBarrier {
    unsigned* bar; unsigned x;
    volatile LAS unsigned* st;
};

__device__ __forceinline__ XcdBarrier xcd_barrier_post(unsigned* bar, volatile LAS unsigned* st) {
    XcdBarrier b; b.bar = bar; b.x = xb_xcc_id(); b.st = st;
    if (threadIdx.x == 0) (void)xb_add(&bar[XB_XCNT(b.x)], 1u);
    return b;
}
__device__ __forceinline__ void xcd_barrier_complete(unsigned* bar, unsigned x, unsigned& nloc, unsigned& nx) {
    const unsigned G = gridDim.x * gridDim.y * gridDim.z;
    unsigned sum, cnt, mine, sp = 0u;
    for (;;) {
        sum = 0u; cnt = 0u; mine = 0u;
#pragma unroll
        for (unsigned j = 0; j < 16; ++j) { const unsigned c = xb_ld(&bar[XB_XCNT(j)]); sum += c; cnt += (c > 0u) ? 1u : 0u; mine = (j == x) ? c : mine; }
        if (sum == G) break;
        __builtin_amdgcn_s_sleep(1);
        if ((++sp & 255u) == 0u) { if (xb_ld(&bar[XB_TMO])) break; if (sp > XB_SPIN_CAP) { atomicAdd(&bar[XB_TMO], 1u); break; } }
    }
    nloc = mine > 0u ? mine : 1u; nx = cnt > 0u ? cnt : 1u;
}

__device__ __forceinline__ void xcd_barrier(const XcdBarrier& b) {
    asm volatile("s_waitcnt vmcnt(0)" ::: "memory");
    __syncthreads();
    if (threadIdx.x == 0) {
        unsigned* bar = b.bar;
        __builtin_amdgcn_s_waitcnt(0);
        unsigned nloc = b.st[0], nx = b.st[1];
        if (nloc == 0u) { xcd_barrier_complete(bar, b.x, nloc, nx); b.st[0] = nloc; b.st[1] = nx; }
        const unsigned old = xb_add(&bar[XB_XSUB(b.x)], 1u);
        const unsigned gen = old / nloc;
        if (old + 1u == (gen + 1u) * nloc) {
            __builtin_amdgcn_fence(__ATOMIC_RELEASE, "agent");
            asm volatile("s_waitcnt vmcnt(0)" ::: "memory");
            const unsigned og = xb_add(&bar[XB_TOP], 1u);
            const unsigned tg = og / nx;
            if (og + 1u == (tg + 1u) * nx) xb_add(&bar[XB_TOPGEN], 1u);
            else XB_SPIN(xb_ld(&bar[XB_TOPGEN]) == tg, bar);
            __builtin_amdgcn_fence(__ATOMIC_ACQUIRE, "agent");
            xb_add(&bar[XB_XGEN(b.x)], 1u);
            asm volatile("s_waitcnt vmcnt(0)" ::: "memory");
        } else {
            XB_SPIN(xb_ld(&bar[XB_XGEN(b.x)]) == gen, bar);
            __builtin_amdgcn_fence(__ATOMIC_ACQUIRE, "agent");
            asm volatile("s_waitcnt vmcnt(0)" ::: "memory");
        }
    }
    __syncthreads();
}

__device__ __forceinline__ void grid_barrier(cg::grid_group& grid) {
    asm volatile("s_waitcnt vmcnt(0)" ::: "memory");
    grid.sync();
    __builtin_amdgcn_fence(__ATOMIC_ACQUIRE, "agent");
    asm volatile("s_waitcnt vmcnt(0)" ::: "memory");
}


#ifdef DBG_STOP
#define DBG_DUMP(k, SRC, LD, COFF) if (DBG_STOP == (k)) { for (int m = gw; m < M; m += NGW) { const unsigned* sr = (const unsigned*)((SRC) + (size_t)m * (LD) + (COFF)); float* orow = p.out + (size_t)m * DM; \
        for (int j = lane; j < DM / 2; j += 64) { const unsigned v = sr[j]; orow[2 * j] = bf_lo(v); orow[2 * j + 1] = bf_hi(v); } } return; }
#else
#define DBG_DUMP(k, SRC, LD, COFF)
#endif

struct Params {
    const float* x; const float* w_in; const float* pool_w; const float* pool_b; const float* pool_scale;
    const float* lb_logits; const float* hgrn_norm_w; const float* w_out;
    const float* n_mix_pre; const float* n_mix_post; const float* n_mlp_pre; const float* n_mlp_post;
    const float* w_mlp_in; const float* w_mlp_out;
    float* out; unsigned char* ws;
};

__global__ void __launch_bounds__(NTHREADS, 2) fwd_megakernel(Params p) {
    extern __shared__ __attribute__((aligned(16))) unsigned char lds_raw[];
    LAS unsigned char* lds = (LAS unsigned char*)lds_raw;
    cg::grid_group grid = cg::this_grid();
    const int G = gridDim.x, bx = blockIdx.x;
    volatile LAS unsigned* xb_st = (volatile LAS unsigned*)(lds + 131072 + 256);
    if (threadIdx.x < 2) xb_st[threadIdx.x] = 0u;
    __syncthreads();
    const XcdBarrier xbar = xcd_barrier_post((unsigned*)(p.ws + WS_BAR), xb_st);
#define SEAM() xcd_barrier(xbar)
    if (G == 0x7fffffff) grid_barrier(grid);
    const int NGW = G * NWAVES;
    unsigned char* ws = p.ws;
    bf16_t* Win_t = (bf16_t*)(ws + WS_WIN); bf16_t* Wout_t = (bf16_t*)(ws + WS_WOUT); bf16_t* W1_t = (bf16_t*)(ws + WS_W1); bf16_t* W2_t = (bf16_t*)(ws + WS_W2);
    bf16_t* Wpool_t = (bf16_t*)(ws + WS_WPOOL);
    float* SS1 = (float*)(ws + WS_SS1); float* SS2 = (float*)(ws + WS_SS2);
    bf16_t* HN = (bf16_t*)(ws + WS_HN); bf16_t* MIX = (bf16_t*)(ws + WS_MIX); bf16_t* DD = (bf16_t*)(ws + WS_D);
    bf16_t* PROJ = (bf16_t*)(ws + WS_PROJ); bf16_t* FFH = (bf16_t*)(ws + WS_FFH);
    float* R2 = (float*)(ws + WS_R2); float* RINV = (float*)(ws + WS_RINV); bf16_t* YB = (bf16_t*)(ws + WS_Y);
    bf16_t* X1B = MIX;
    unsigned* SSB1 = (unsigned*)(ws + WS_SS1); unsigned* SSB1B = (unsigned*)(ws + WS_SS1 + 2 * MiB); unsigned* SSB2 = (unsigned*)(ws + WS_SS2);
    unsigned* CNT_A = (unsigned*)(ws + 131072); unsigned* CNT_B = CNT_A + 128 * 16; unsigned* CNT_C = CNT_B + 128 * 16;
    unsigned* qctr = (unsigned*)ws;

#ifndef PHMASK
#define PHMASK 0x1ff
#endif
#if (PHMASK>>0)&1
    {
        const int tid = opaque_tid(), lane = tid & 63, wave = __builtin_amdgcn_readfirstlane(tid >> 6), gw = bx * NWAVES + wave;
        if (bx == 0 && tid == 0) __hip_atomic_store(qctr, 0u, __ATOMIC_RELAXED, __HIP_MEMORY_SCOPE_AGENT);
        LAS float* scr = (LAS float*)(lds + wave * 16384);
        constexpr int I_IN = (DM / 64) * (INW / 32), I_P = (256 / 64) * (256 / 32);
        constexpr int NITEMS = I_IN + 4 * I_P;
        for (int it = gw; it < NITEMS; it += NGW) {
            int r = it;
            if (r < I_IN) { p0_transpose_item(p.w_in, DM, INW, Win_t, scr, r, lane, nullptr, p.n_mix_pre); continue; } r -= I_IN;
            const int j = r / I_P; r -= j * I_P;
            p0_transpose_item(p.pool_w + (size_t)j * 256 * 256, 256, 256, Wpool_t + (size_t)j * 256 * 256, scr, r, lane, p.pool_scale + j * 256);
        }
        {
            int m = gw;
            for (; m + 3 * NGW < M; m += 4 * NGW) rms_rows_to_bf16<4>(p.x, RINV, HN, m, NGW, lane);
            for (; m < M; m += NGW) rms_rows_to_bf16<1>(p.x, RINV, HN, m, NGW, lane);
        }
    }
    SEAM();

#endif
#if (PHMASK>>1)&1
    {
        pg8::Gemm g{HN, Win_t, DM, DM, DM, 0}; pg8::StaticOrder S; S.init(M, INW, G, bx);
        pg8::Epi<4> E{PROJ, INW, p.lb_logits, nullptr, nullptr};
        pg8::gemm_phase(lds, g, S, E);
    }
    SEAM();
    DBG_DUMP(1, PROJ, INW, 1024)
#endif
#if (PHMASK>>2)&1
    {
        const int NH = (G / 2 < NB * NHEAD) ? G / 2 : NB * NHEAD;
        if (bx < NH) {
            for (int u = bx; u < NB * NHEAD; u += NH) hgrn_unit(lds, PROJ, YB, p.hgrn_norm_w, u);
        } else {
            const int NP = G - NH, pb = bx - NH;
            for (int pm = pb; pm < M / 256; pm += NP)
                for (int k = 0; k < 4; ++k) pool_diff_unit(PROJ, DD, pm * 4 + k);
            __threadfence(); __builtin_amdgcn_fence(__ATOMIC_ACQUIRE, "agent"); __syncthreads();
            {
                pg8::Gemm g{DD, Wpool_t, PW, 256, 256, 512}; pg8::PanelOrder S{pb, NP, M / 256};
                pg8::Epi<2> E{YB, DM, p.pool_b, p.pool_scale, nullptr};
                pg8::gemm_phase(lds, g, S, E);
            }
        }
        {
            const int tid = opaque_tid(), lane = tid & 63, wave = __builtin_amdgcn_readfirstlane(tid >> 6);
            LAS float* scr = (LAS float*)(lds + wave * 16384);
            constexpr int I_OUT = (DM / 64) * (DM / 32), I_1 = (DM / 64) * (FFW / 32), I_2 = (FFW / 64) * (DM / 32);
            constexpr int QB = 8;
            for (;;) {
                int base = 0;
                if (lane == 0) base = (int)__hip_atomic_fetch_add(qctr, (unsigned)QB, __ATOMIC_RELAXED, __HIP_MEMORY_SCOPE_AGENT);
                base = __builtin_amdgcn_readfirstlane(base);
                if (base >= I_OUT + I_1 + I_2) break;
                for (int it = base; it < base + QB && it < I_OUT + I_1 + I_2; ++it) {
                    int r = it;
                    if (r < I_OUT) { p0_transpose_item(p.w_out, DM, DM, Wout_t, scr, r, lane); continue; } r -= I_OUT;
                    if (r < I_1) { p0_transpose_item(p.w_mlp_in, DM, FFW, W1_t, scr, r, lane, nullptr, p.n_mlp_pre); continue; } r -= I_1;
                    p0_transpose_item(p.w_mlp_out, FFW, DM, W2_t, scr, r, lane);
                }
            }
        }
    }
    SEAM();

#endif
#if (PHMASK>>4)&1
    {
        pg8::Gemm g{YB, Wout_t, DM, DM, DM, 0}; pg8::FusedOrder S{bx, G, M / 256};
        pg8::EpiFused<5> E{nullptr, HN, X1B, nullptr, p.n_mix_post, SSB1, CNT_A, SSB1B, CNT_B, R2, RINV};
        pg8::gemm_phase(lds, g, S, E);
    }
    SEAM();
#endif
#if (PHMASK>>5)&1
#endif
#if (PHMASK>>6)&1
    {
        pg8::Gemm g{X1B, W1_t, DM, DM, DM, 0}; pg8::StaticOrder S; S.init(M, FFW, G, bx);
        pg8::Epi<1> E{FFH, FFW, nullptr, R2, nullptr};
        pg8::gemm_phase(lds, g, S, E);
    }
    SEAM();
    DBG_DUMP(6, FFH, FFW, 0)
#endif
#if (PHMASK>>7)&1
    {
        pg8::Gemm g{FFH, W2_t, FFW, FFW, FFW, 0}; pg8::FusedOrder S{bx, G, M / 256};
        pg8::EpiFused<6> E{nullptr, X1B, nullptr, p.out, p.n_mlp_post, SSB2, CNT_C, nullptr, nullptr, nullptr, nullptr};
        pg8::gemm_phase(lds, g, S, E);
    }
#endif
}

extern "C" void kernel_launch(void* const* d_in, const int* in_sizes, int n_in, void* d_out, int out_size, void* d_ws, size_t ws_size, hipStream_t stream) {
    static int grid_blocks = 0;
    if (grid_blocks == 0) {
        if (n_in != 14 || in_sizes[0] != M * DM || out_size != M * DM || ws_size < WS_END) { fprintf(stderr, "kernel_launch: unexpected shapes (n_in %d, in0 %d, out %d, ws %zu)\n", n_in, n_in > 0 ? in_sizes[0] : -1, out_size, ws_size); grid_blocks = -1; return; }
        int dev = 0, cus = 0, per_cu = 0;
        hipGetDevice(&dev);
        hipDeviceGetAttribute(&cus, hipDeviceAttributeMultiprocessorCount, dev);
        if (hipFuncSetAttribute((const void*)fwd_megakernel, hipFuncAttributeMaxDynamicSharedMemorySize, LDS_BYTES) != hipSuccess) { fprintf(stderr, "kernel_launch: hipFuncSetAttribute failed\n"); grid_blocks = -1; return; }
        if (hipOccupancyMaxActiveBlocksPerMultiprocessor(&per_cu, (const void*)fwd_megakernel, NTHREADS, LDS_BYTES) != hipSuccess || per_cu < 1) { fprintf(stderr, "kernel_launch: occupancy query says %d\n", per_cu); per_cu = 1; }
        (void)hipGetLastError();
        if (per_cu > 1) per_cu = 1;
        grid_blocks = cus * per_cu;
    }
    if (grid_blocks < 0) return;
    Params p{};
    p.x = (const float*)d_in[0]; p.w_in = (const float*)d_in[1]; p.pool_w = (const float*)d_in[2]; p.pool_b = (const float*)d_in[3]; p.pool_scale = (const float*)d_in[4];
    p.lb_logits = (const float*)d_in[5]; p.hgrn_norm_w = (const float*)d_in[6]; p.w_out = (const float*)d_in[7];
    p.n_mix_pre = (const float*)d_in[8]; p.n_mix_post = (const float*)d_in[9]; p.n_mlp_pre = (const float*)d_in[10]; p.n_mlp_post = (const float*)d_in[11];
    p.w_mlp_in = (const float*)d_in[12]; p.w_mlp_out = (const float*)d_in[13];
    p.out = (float*)d_out; p.ws = (unsigned char*)d_ws;
    static_assert(131072 + 3 * 128 * 16 * 4 <= 160 * 1024 && WS_BAR + 16384 <= 131072, "control words inside the zeroed 160 KiB");
    if (hipMemsetAsync(d_ws, 0, 160 * 1024, stream) != hipSuccess) { fprintf(stderr, "kernel_launch: hipMemsetAsync failed\n"); return; }
    void* args[] = {&p};
    hipError_t e = hipLaunchCooperativeKernel((const void*)fwd_megakernel, dim3(grid_blocks), dim3(NTHREADS), args, LDS_BYTES, stream);
    if (e != hipSuccess) fprintf(stderr, "cooperative launch failed: %s (grid %d)\n", hipGetErrorString(e), grid_blocks);
}
```
